# Optimizing an MI355X kernel written in HIP

```python
import jax, jax.numpy as jnp
from jax import lax
import numpy as np

D_MODEL = 2048
BATCH = 4
SEQ = 8192
DEPTH = 1

GLA_HEADS = 4
GLA_KEY_DIM = D_MODEL // 2
GLA_VALUE_DIM = D_MODEL
GLA_HEAD_K = GLA_KEY_DIM // GLA_HEADS
GLA_HEAD_V = GLA_VALUE_DIM // GLA_HEADS
GLA_GATE_RANK = 16
GLA_GATE_NORMALIZER = 16.0
GLA_CHUNK = 64
POOL_WINDOWS = (2, 4, 8, 16)
POOL_GROUPS = 4
POOL_DIM = D_MODEL // 2
POOL_GROUP_DIM = POOL_DIM // POOL_GROUPS
IN_SPLITS = (GLA_KEY_DIM, GLA_KEY_DIM, GLA_VALUE_DIM, GLA_VALUE_DIM, GLA_GATE_RANK, POOL_DIM, D_MODEL, D_MODEL)
IN_DIM = 2 * GLA_KEY_DIM + 2 * GLA_VALUE_DIM + GLA_GATE_RANK + POOL_DIM + 2 * D_MODEL
N_GROUPS = 8
EXPERTS_PER_GROUP = 8
N_EXPERTS = N_GROUPS * EXPERTS_PER_GROUP
TOP_K = 2
EXPERT_HIDDEN = D_MODEL // 2
MOE_BLOCK = 128
NORM_EPS = 1e-6

kernel_name = "hybrid_gla_pool_hiermoe_adaln"


def rms_norm(x, gain):
    xf = x.astype(jnp.float32)
    y = xf * lax.rsqrt(jnp.mean(xf * xf, axis=-1, keepdims=True) + NORM_EPS)
    return (y * gain.astype(jnp.float32)).astype(x.dtype)


def modulate(x, shift, scale):
    return x * (1 + scale[:, None, :]) + shift[:, None, :]


def split_cols(z, sizes):
    outs, off = [], 0
    for s in sizes:
        outs.append(z[..., off:off + s])
        off += s
    return outs


def gla_chunked(q, k, v, log_a):
    B, H, S, dk = q.shape
    dv = v.shape[-1]
    C = GLA_CHUNK
    N = S // C
    q, k, log_a = (t.reshape(B, H, N, C, dk) for t in (q, k, log_a))
    v = v.reshape(B, H, N, C, dv)
    b = jnp.cumsum(log_a, axis=3)
    b_last = b[:, :, :, -1:, :]
    q_e = q * jnp.exp(b)
    k_e = k * jnp.exp(-b)
    k_dec = k * jnp.exp(b_last - b)
    causal = jnp.tril(jnp.ones((C, C), dtype=bool))
    att = jnp.einsum('bhnid,bhnjd->bhnij', q_e, k_e)
    att = jnp.where(causal, att, 0.0)
    o_intra = jnp.einsum('bhnij,bhnjv->bhniv', att, v)
    decay = jnp.exp(b_last[:, :, :, 0, :])

    def step(state, xs):
        qn, kn, vn, dn = xs
        o = jnp.einsum('bhid,bhdv->bhiv', qn, state)
        state = dn[..., None] * state + jnp.einsum('bhid,bhiv->bhdv', kn, vn)
        return state, o

    xs = tuple(jnp.moveaxis(t, 2, 0) for t in (q_e, k_dec, v, decay))
    _, o_inter = lax.scan(step, jnp.zeros((B, H, dk, dv), jnp.float32), xs)
    o = o_intra + jnp.moveaxis(o_inter, 0, 2)
    return o.reshape(B, H, S, dv)


def gla_branch(q, k, v, g, gk_lr, w_gk2, b_gk2, gla_norm):
    B, S, _ = q.shape
    heads = lambda t, d: t.reshape(B, S, GLA_HEADS, d).transpose(0, 2, 1, 3).astype(jnp.float32)
    qh = heads(q, GLA_HEAD_K) * (GLA_HEAD_K ** -0.5)
    kh = heads(k, GLA_HEAD_K)
    vh = heads(v, GLA_HEAD_V)
    log_a = jax.nn.log_sigmoid((gk_lr @ w_gk2 + b_gk2).astype(jnp.float32)) / GLA_GATE_NORMALIZER
    o = gla_chunked(qh, kh, vh, heads(log_a, GLA_HEAD_K))
    o = o.transpose(0, 2, 1, 3)
    o = rms_norm(o, gla_norm) * jax.nn.silu(g.reshape(B, S, GLA_HEADS, GLA_HEAD_V).astype(jnp.float32))
    return o.reshape(B, S, GLA_VALUE_DIM).astype(q.dtype)


def pool_branch(p, w_pool, pool_scale):
    B, S, _ = p.shape
    pf = p.astype(jnp.float32).reshape(B, S, POOL_GROUPS, POOL_GROUP_DIM)
    cs = jnp.cumsum(pf, axis=1)
    pos = jnp.arange(S)
    outs = []
    for gi, w in enumerate(POOL_WINDOWS):
        csg = cs[:, :, gi]
        lagged = jnp.pad(csg, ((0, 0), (w, 0), (0, 0)))[:, :S]
        count = jnp.minimum(pos + 1, w).astype(jnp.float32)[None, :, None]
        outs.append((csg - lagged) / count - pf[:, :, gi])
    m = jnp.stack(outs, axis=2)
    y = jnp.einsum('bsgc,gcd->bsgd', m, w_pool.astype(jnp.float32))
    return (y.reshape(B, S, POOL_DIM) * pool_scale.astype(jnp.float32)).astype(p.dtype)


def hier_moe(u, w_rg, b_rg, w_re, b_re, w_gate, w_up, w_down):
    B, S, D = u.shape
    T = B * S
    xt = u.reshape(T, D)
    glog = (xt @ w_rg).astype(jnp.float32) + b_rg.astype(jnp.float32)
    gprob = jax.nn.softmax(glog, axis=-1)
    gsel = jnp.argmax(glog, axis=-1).astype(jnp.int32)
    pg = jnp.take_along_axis(gprob, gsel[:, None], axis=1)[:, 0]
    elog = ((xt @ w_re).astype(jnp.float32) + b_re.astype(jnp.float32)).reshape(T, N_GROUPS, EXPERTS_PER_GROUP)
    elog = jnp.take_along_axis(elog, gsel[:, None, None], axis=1)[:, 0]
    eprob = jax.nn.softmax(elog, axis=-1)
    topv, topi = lax.top_k(eprob, TOP_K)
    topv = topv / jnp.sum(topv, axis=-1, keepdims=True)
    wts = (pg[:, None] * topv).reshape(-1)
    eid = (gsel[:, None] * EXPERTS_PER_GROUP + topi).reshape(-1).astype(jnp.int32)
    tok = jnp.repeat(jnp.arange(T, dtype=jnp.int32), TOP_K)
    A = T * TOP_K
    order = jnp.argsort(eid)
    e_sorted = eid[order]
    counts = jnp.bincount(eid, length=N_EXPERTS)
    starts = jnp.cumsum(counts) - counts
    padded = (counts + MOE_BLOCK - 1) // MOE_BLOCK * MOE_BLOCK
    pends = jnp.cumsum(padded)
    pstarts = pends - padded
    dest = pstarts[e_sorted] + jnp.arange(A, dtype=jnp.int32) - starts[e_sorted]
    P = (A + MOE_BLOCK - 1) // MOE_BLOCK * MOE_BLOCK + N_EXPERTS * MOE_BLOCK
    n_blocks = P // MOE_BLOCK
    buf_tok = jnp.full((P,), T, jnp.int32).at[dest].set(tok[order])
    buf_w = jnp.zeros((P,), jnp.float32).at[dest].set(wts[order])
    blk_e = jnp.clip(jnp.searchsorted(pends, jnp.arange(n_blocks, dtype=jnp.int32) * MOE_BLOCK, side='right'),
                     0, N_EXPERTS - 1)
    x_pad = jnp.concatenate([xt, jnp.zeros((1, D), xt.dtype)], axis=0)

    def expert_block(args):
        tb, wb, e = args
        xb = x_pad[tb]
        hdn = jax.nn.silu(xb @ w_gate[e]) * (xb @ w_up[e])
        return (hdn @ w_down[e]) * wb[:, None].astype(xb.dtype)

    yb = lax.map(expert_block, (buf_tok.reshape(n_blocks, MOE_BLOCK), buf_w.reshape(n_blocks, MOE_BLOCK), blk_e))
    y = jax.ops.segment_sum(yb.reshape(P, D), buf_tok, num_segments=T + 1)[:T]
    return y.reshape(B, S, D)


def setup_inputs(seed: int = 0) -> dict:
    key = jax.random.key(seed)
    ks = jax.random.split(key, 24)
    L, D = DEPTH, D_MODEL
    nrm = lambda k, shape, s: jax.random.normal(k, shape, jnp.float32) * s
    return {
        "x": nrm(ks[0], (BATCH, SEQ, D), 1.0),
        "c": nrm(ks[1], (BATCH, D), 1.0),
        "w_ada": nrm(ks[2], (L, D, 6 * D), 0.5 * D ** -0.5),
        "b_ada": nrm(ks[3], (L, 6 * D), 0.02),
        "norm_mix": 1.0 + nrm(ks[4], (L, D), 0.02),
        "w_in": nrm(ks[5], (L, D, IN_DIM), D ** -0.5),
        "w_gk2": nrm(ks[6], (L, GLA_GATE_RANK, GLA_KEY_DIM), GLA_GATE_RANK ** -0.5),
        "b_gk2": nrm(ks[7], (L, GLA_KEY_DIM), 0.1),
        "gla_norm": 1.0 + nrm(ks[8], (L, GLA_HEAD_V), 0.02),
        "w_a": nrm(ks[9], (L, GLA_VALUE_DIM, D), GLA_VALUE_DIM ** -0.5),
        "w_pool": nrm(ks[10], (L, POOL_GROUPS, POOL_GROUP_DIM, POOL_GROUP_DIM), POOL_GROUP_DIM ** -0.5),
        "pool_scale": 1.0 + nrm(ks[11], (L, POOL_DIM), 0.1),
        "w_b": nrm(ks[12], (L, POOL_DIM, D), POOL_DIM ** -0.5),
        "w_out": nrm(ks[13], (L, D, D), D ** -0.5),
        "norm_ffn": 1.0 + nrm(ks[14], (L, D), 0.02),
        "w_rg": nrm(ks[15], (L, D, N_GROUPS), D ** -0.5),
        "b_rg": nrm(ks[16], (L, N_GROUPS), 0.01),
        "w_re": nrm(ks[17], (L, D, N_EXPERTS), D ** -0.5),
        "b_re": nrm(ks[18], (L, N_EXPERTS), 0.01),
        "w_gate": nrm(ks[19], (L, N_EXPERTS, D, EXPERT_HIDDEN), D ** -0.5),
        "w_up": nrm(ks[20], (L, N_EXPERTS, D, EXPERT_HIDDEN), D ** -0.5),
        "w_down": nrm(ks[21], (L, N_EXPERTS, EXPERT_HIDDEN, D), EXPERT_HIDDEN ** -0.5),
        "norm_final": 1.0 + nrm(ks[22], (D,), 0.02),
    }


def reference(x, c, w_ada, b_ada, norm_mix, w_in, w_gk2, b_gk2, gla_norm, w_a, w_pool, pool_scale, w_b, w_out,
              norm_ffn, w_rg, b_rg, w_re, b_re, w_gate, w_up, w_down, norm_final):
    h = x
    for l in range(DEPTH):
        mod = jax.nn.silu(c) @ w_ada[l] + b_ada[l]
        shift1, scale1, gate1, shift2, scale2, gate2 = jnp.split(mod, 6, axis=-1)
        u = modulate(rms_norm(h, norm_mix[l]), shift1, scale1)
        z = u @ w_in[l]
        q, k, v, g, gk_lr, p, ga, gb = split_cols(z, IN_SPLITS)
        y_a = gla_branch(q, k, v, g, gk_lr, w_gk2[l], b_gk2[l], gla_norm[l]) @ w_a[l]
        y_b = pool_branch(p, w_pool[l], pool_scale[l]) @ w_b[l]
        merged = jax.nn.sigmoid(ga) * y_a + jax.nn.sigmoid(gb) * y_b
        h = h + gate1[:, None, :] * (merged @ w_out[l])
        u2 = modulate(rms_norm(h, norm_ffn[l]), shift2, scale2)
        h = h + gate2[:, None, :] * hier_moe(u2, w_rg[l], b_rg[l], w_re[l], b_re[l], w_gate[l], w_up[l], w_down[l])
    return rms_norm(h, norm_final)
```

```cpp
#include <hip/hip_runtime.h>
#include <cstdio>
#include <cstdint>

#define GAS __attribute__((address_space(1)))
#define LAS __attribute__((address_space(3)))
typedef unsigned short bf16;
typedef short bf16x8 __attribute__((ext_vector_type(8)));
typedef float f32x4 __attribute__((ext_vector_type(4)));
typedef float f32x2 __attribute__((ext_vector_type(2)));
typedef unsigned u32x4 __attribute__((ext_vector_type(4)));
typedef unsigned u32x2 __attribute__((ext_vector_type(2)));
typedef int i32x4 __attribute__((ext_vector_type(4)));
typedef int i32x8 __attribute__((ext_vector_type(8)));

constexpr int D = 2048, NB = 4, SEQ = 8192, T = NB * SEQ;
constexpr int NZ = 11264, NZP = 11520, IN_DIM = 11280;
constexpr int NEXP = 64, EH = 1024;
constexpr int MAXSLOT = 81920;
constexpr float EPS = 1e-6f;
constexpr int NWAVES = 8, NTHR = 512;
constexpr int KSPLIT = 10, KSPL = 205;

constexpr size_t MiB = 1u << 20;
constexpr size_t WS_CTL = 0, CTL_ZERO_BYTES = 128 * 1024;
constexpr size_t WS_MODP = 1 * MiB;
constexpr size_t WS_MODF = 3 * MiB;
constexpr size_t WS_WRT = 4 * MiB;
constexpr size_t WS_WIN = 5 * MiB;
constexpr size_t WS_WA = 50 * MiB;
constexpr size_t WS_WPB = 58 * MiB;
constexpr size_t WS_WOUT = 62 * MiB;
constexpr size_t WS_WGU = 70 * MiB;
constexpr size_t WS_U8 = 326 * MiB;
constexpr size_t WS_WIN8 = 400 * MiB;
constexpr size_t WS_WD = 582 * MiB;
constexpr size_t WS_LIST = 838 * MiB;
constexpr size_t WS_ASG = 846 * MiB;
constexpr size_t WS_ASGW = WS_ASG + (size_t)T * 16;
constexpr size_t WS_U = 848 * MiB;
constexpr size_t WS_Z = 976 * MiB;
constexpr size_t WS_Q = WS_Z, WS_K = WS_Z + 64 * MiB, WS_V = WS_Z + 128 * MiB, WS_G = WS_Z + 256 * MiB, WS_P = WS_Z + 384 * MiB,
                 WS_GA = WS_Z + 448 * MiB, WS_GB = WS_Z + 576 * MiB, WS_GKLR = WS_Z + 704 * MiB;
constexpr size_t WS_GLA = 1682 * MiB;
constexpr size_t WS_KDT = WS_GLA, WS_ATT = WS_GLA + 64 * MiB, WS_DEC = WS_GLA + 80 * MiB, WS_O = WS_GLA + 82 * MiB, WS_M = WS_GLA + 210 * MiB;
constexpr size_t WS_RSS = 1956 * MiB;
constexpr size_t WS_END = 1960 * MiB;
constexpr size_t WS_H1 = WS_O;
constexpr size_t WS_Y = WS_Z;
constexpr size_t WS_H = WS_Z + 320 * MiB;
static_assert(WS_H + (size_t)MAXSLOT * EH * 2 <= WS_GKLR, "H/Y overlay");
constexpr int CW_TMO = 0, CW_BAR = 4096, CW_CNT = 8192;

constexpr int RING_BYTES = 131072;
constexpr int LDS_MISC = RING_BYTES;
constexpr int LDS_BYTES = 150 * 1024;

#define RLX_AGENT __ATOMIC_RELAXED, __HIP_MEMORY_SCOPE_AGENT
#define LDS_WAIT() asm volatile("s_waitcnt lgkmcnt(0)" ::: "memory")
#define VM_WAIT() asm volatile("s_waitcnt vmcnt(0)" ::: "memory")
typedef __bf16 bf16x2_t __attribute__((ext_vector_type(2)));
__device__ __forceinline__ unsigned cvt_pk_bf16(float lo, float hi) { const f32x2 v = {lo, hi}; return __builtin_bit_cast(unsigned, __builtin_convertvector(v, bf16x2_t)); }
__device__ __forceinline__ unsigned pk4_fp8(float a, float b, float c, float d) { int w = 0; w = __builtin_amdgcn_cvt_pk_fp8_f32(a, b, w, false); w = __builtin_amdgcn_cvt_pk_fp8_f32(c, d, w, true); return (unsigned)w; }
__device__ __forceinline__ float sat8(float v) { return __builtin_amdgcn_fmed3f(v, 448.0f, -448.0f); }
constexpr float W8_SCALE = 64.0f, H8_SCALE = 16.0f, Y8_SCALE = 16.0f;
__device__ __forceinline__ float bf_lo(unsigned w) { return __uint_as_float(w << 16); }
__device__ __forceinline__ float bf_hi(unsigned w) { return __uint_as_float(w & 0xffff0000u); }
__device__ __forceinline__ float dpp_add_(float v, const int ctrl_sel) {
    int r;
    if (ctrl_sel == 0) r = __builtin_amdgcn_update_dpp(0, __builtin_bit_cast(int, v), 0xB1, 0xf, 0xf, false);
    else if (ctrl_sel == 1) r = __builtin_amdgcn_update_dpp(0, __builtin_bit_cast(int, v), 0x4E, 0xf, 0xf, false);
    else if (ctrl_sel == 2) r = __builtin_amdgcn_update_dpp(0, __builtin_bit_cast(int, v), 0x141, 0xf, 0xf, false);
    else r = __builtin_amdgcn_update_dpp(0, __builtin_bit_cast(int, v), 0x140, 0xf, 0xf, false);
    return v + __builtin_bit_cast(float, r);
}
__device__ __forceinline__ float wave_sum(float v) {
    v = dpp_add_(v, 0); v = dpp_add_(v, 1); v = dpp_add_(v, 2); v = dpp_add_(v, 3);
    const float a = __builtin_bit_cast(float, __builtin_amdgcn_readlane(__builtin_bit_cast(int, v), 0)), b = __builtin_bit_cast(float, __builtin_amdgcn_readlane(__builtin_bit_cast(int, v), 16));
    const float c = __builtin_bit_cast(float, __builtin_amdgcn_readlane(__builtin_bit_cast(int, v), 32)), d = __builtin_bit_cast(float, __builtin_amdgcn_readlane(__builtin_bit_cast(int, v), 48));
    return (a + b) + (c + d);
}
__device__ __forceinline__ float sigmoidf_(float x) { return __builtin_amdgcn_rcpf(1.0f + __expf(-x)); }
__device__ __forceinline__ float siluf_(float x) { return x * __builtin_amdgcn_rcpf(1.0f + __expf(-x)); }

#define XB_TMO      128
#define XB_XCNT(j)  (256  + 64 * (j))
#define XB_XSUB(j)  (1280 + 64 * (j))
#define XB_XGEN(j)  (2304 + 64 * (j))
#define XB_TOP      3328
#define XB_TOPGEN   3392
#define XCD_BAR_WORDS 3456
#define XB_SPIN_CAP (1u << 18)
__device__ __forceinline__ unsigned xb_ld(unsigned* p)              { return __hip_atomic_load(p, __ATOMIC_RELAXED, __HIP_MEMORY_SCOPE_AGENT); }
__device__ __forceinline__ unsigned xb_add(unsigned* p, unsigned v) { return __hip_atomic_fetch_add(p, v, __ATOMIC_RELAXED, __HIP_MEMORY_SCOPE_AGENT); }
__device__ __forceinline__ unsigned xb_xcc_id() { return (unsigned)__builtin_amdgcn_s_getreg((3 << 11) | 20) & 0xFu; }
#define XB_SPIN(cond, bar) do { unsigned _sp = 0; while (cond) { __builtin_amdgcn_s_sleep(1); \
    if ((++_sp & 255u) == 0u) { if (xb_ld(&(bar)[XB_TMO])) break; if (_sp > XB_SPIN_CAP) { atomicAdd(&(bar)[XB_TMO], 1u); break; } } } } while (0)
struct XcdBarrier { unsigned* bar; unsigned x; volatile LAS unsigned* st; };
__device__ __forceinline__ XcdBarrier xcd_barrier_post(unsigned* bar, volatile LAS unsigned* st) {
    XcdBarrier b; b.bar = bar; b.x = xb_xcc_id(); b.st = st;
    if (threadIdx.x == 0) (void)xb_add(&bar[XB_XCNT(b.x)], 1u);
    return b;
}
__device__ __forceinline__ void xcd_barrier_complete(unsigned* bar, unsigned x, unsigned& nloc, unsigned& nx) {
    const unsigned G = gridDim.x * gridDim.y * gridDim.z;
    unsigned sum, cnt, mine, sp = 0u;
    for (;;) {
        sum = 0u; cnt = 0u; mine = 0u;
#pragma unroll
        for (unsigned j = 0; j < 16; ++j) { const unsigned c = xb_ld(&bar[XB_XCNT(j)]); sum += c; cnt += (c > 0u) ? 1u : 0u; mine = (j == x) ? c : mine; }
        if (sum == G) break;
        __builtin_amdgcn_s_sleep(1);
        if ((++sp & 255u) == 0u) { if (xb_ld(&bar[XB_TMO])) break; if (sp > XB_SPIN_CAP) { atomicAdd(&bar[XB_TMO], 1u); break; } }
    }
    nloc = mine > 0u ? mine : 1u; nx = cnt > 0u ? cnt : 1u;
}
__device__ __forceinline__ void xcd_barrier(const XcdBarrier& b) {
    asm volatile("s_waitcnt vmcnt(0)" ::: "memory");
    __syncthreads();
    if (threadIdx.x == 0) {
        unsigned* bar = b.bar;
        __builtin_amdgcn_s_waitcnt(0);
        unsigned nloc = b.st[0], nx = b.st[1];
        if (nloc == 0u) { xcd_barrier_complete(bar, b.x, nloc, nx); b.st[0] = nloc; b.st[1] = nx; }
        const unsigned old = xb_add(&bar[XB_XSUB(b.x)], 1u);
        const unsigned gen = old / nloc;
        if (old + 1u == (gen + 1u) * nloc) {
            __builtin_amdgcn_fence(__ATOMIC_RELEASE, "agent");
            asm volatile("s_waitcnt vmcnt(0)" ::: "memory");
            const unsigned og = xb_add(&bar[XB_TOP], 1u);
            const unsigned tg = og / nx;
            if (og + 1u == (tg + 1u) * nx) xb_add(&bar[XB_TOPGEN], 1u);
            else XB_SPIN(xb_ld(&bar[XB_TOPGEN]) == tg, bar);
            __builtin_amdgcn_fence(__ATOMIC_ACQUIRE, "agent");
            xb_add(&bar[XB_XGEN(b.x)], 1u);
            asm volatile("s_waitcnt vmcnt(0)" ::: "memory");
        } else {
            XB_SPIN(xb_ld(&bar[XB_XGEN(b.x)]) == gen, bar);
            __builtin_amdgcn_fence(__ATOMIC_ACQUIRE, "agent");
            asm volatile("s_waitcnt vmcnt(0)" ::: "memory");
        }
    }
    __syncthreads();
}

struct Args {
    const float* in[23];
    float* out; unsigned char* ws;
    int ph_lo, ph_hi, mode, pad;
};
enum { I_X = 0, I_C, I_WADA, I_BADA, I_NMIX, I_WIN, I_WGK2, I_BGK2, I_GLAN, I_WA, I_WPOOL, I_PSCALE, I_WB, I_WOUT, I_NFFN, I_WRG, I_BRG, I_WRE, I_BRE, I_WGATE, I_WUP, I_WDOWN, I_NFIN };
constexpr int NPH = 13;

struct Frame {
    LAS unsigned char* lds;
    int tid, lane, wave, G, wg;
    const Args* a;
    unsigned char* ws;
};


namespace pg8 {
constexpr int BM = 256, BK = 64, HALF = 128, HTB = HALF * BK * 2, STAGE_BYTES = 8 * HTB, NXCD = 8, WGM = 8;
__host__ __device__ __forceinline__ int lds_byte(int r, int c) { const int st = (r >> 4) * 2 + (c >> 5), rr = r & 15, cc = c & 31, ob = rr * 64 + cc * 2; return st * 1024 + (ob ^ (((ob >> 9) & 1) << 5)); }
__host__ __device__ __forceinline__ void stage_rc(int b, int& R, int& C) { const int st = b / 1024, sb = b % 1024, swz = sb ^ (((sb >> 9) & 1) << 5); R = (st >> 1) * 16 + swz / 64; C = (st & 1) * 32 + (swz % 64) / 2; }
__host__ __device__ __forceinline__ int perm32(int rho) { const int n = rho >> 4, i = rho & 15; return 8 * (i >> 2) + 4 * n + (i & 3); }
struct Unit { int pm, pn, e, r0, nrows; };

struct StaticOrder {
    static constexpr bool HALF = false;
    int nM, nN, nwg, G, c, off, lim;
    __device__ void init(int M, int N, int G_, int c_) { nM = M / BM; nN = N / BM; nwg = nM * nN; G = G_; c = c_; off = 0; lim = nwg; }
    __device__ bool next(int i, Unit& u) const {
        const long L = (long)i * G + c + off; if (L >= lim) return false;
        int wgid = (int)L; { const int q = nwg / NXCD, r = nwg % NXCD, xcd = wgid % NXCD, off = wgid / NXCD; wgid = (xcd < r ? xcd * (q + 1) : r * (q + 1) + (xcd - r) * q) + off; }
        const int nig = WGM * nN, gid = wgid / nig, fm = gid * WGM, gsz = (nM - fm) < WGM ? (nM - fm) : WGM;
        u.pm = fm + ((wgid % nig) % gsz); u.pn = (wgid % nig) / gsz; u.e = 0; u.r0 = 0; u.nrows = 256; return true;
    }
};
struct GroupOrder {
    static constexpr bool HALF = true;
    const volatile LAS int* tb; const volatile LAS int* cnt; const volatile LAS int* fl; const volatile LAS int* hl; const volatile LAS int* nfh; int G, c;
    __device__ bool next(int i, Unit& u) const {
        const int s = 4 * (c & 7) + (c >> 6), pn = (c >> 3) & 7;
        const int Fn = __builtin_amdgcn_readfirstlane(nfh[0]), Hn = __builtin_amdgcn_readfirstlane(nfh[1]);
        const int q = Fn >> 5, r = Fn & 31, nfull = q + (s < r ? 1 : 0);
        int mt;
        if (i < nfull) mt = __builtin_amdgcn_readfirstlane(fl[s + 32 * i]);
        else {
            const int k = i - nfull, cap = 2 * (32 - r), H1 = Hn < cap ? Hn : cap;
            int n1 = 0; if (s >= r) n1 = ((s - r) < H1 ? 1 : 0) + ((s - r) + (32 - r) < H1 ? 1 : 0);
            int hidx;
            if (k < n1) hidx = (s - r) + (32 - r) * k; else hidx = cap + s + 32 * (k - n1);
            if (hidx >= Hn) return false;
            mt = __builtin_amdgcn_readfirstlane(hl[hidx]);
        }
        int e = 0;
#pragma unroll
        for (int st = 32; st >= 1; st >>= 1) { const int t = __builtin_amdgcn_readfirstlane(tb[e + st]); if (t <= mt) e += st; }
        u.pm = mt; u.pn = pn; u.e = e; u.r0 = (mt - __builtin_amdgcn_readfirstlane(tb[e])) * 256; u.nrows = __builtin_amdgcn_readfirstlane(cnt[e]) - u.r0; return true;
    }
};

template <class Epi, class Sched, class Src>
__device__ __forceinline__ void gemm_phase(LAS unsigned char* lds, const Sched& S, const Src& X, const Epi& E) {
    const int tid = threadIdx.x, wid = __builtin_amdgcn_readfirstlane(tid >> 6), lane = tid & 63, wr = wid >> 2, wc = wid & 3, fr = lane & 15, fq = lane >> 4;
    constexpr int ES = Src::FP8 ? 1 : 2;
    const int K = X.K, nt = K / (Src::FP8 ? 2 * BK : BK);
    int Rr[2], Cc[2];
    unsigned voffB[2];
#pragma unroll
    for (int i = 0; i < 2; ++i) { stage_rc(tid * 16 + i * 8192, Rr[i], Cc[i]); const int Rb = Epi::PERM ? ((Rr[i] & ~31) + perm32(Rr[i] & 31)) : Rr[i]; voffB[i] = Src::BTILED ? (unsigned)(Rb * BK + Cc[i]) * 2u : (unsigned)(Rb * X.ldb) * ES + 2u * Cc[i]; }
    const size_t kstep = (size_t)(BK * 2);
    const size_t kstepB = Src::BTILED ? (size_t)(BM * BK * 2) : kstep;
    const size_t hstepB = Src::BTILED ? (size_t)(HALF * BK * 2) : (size_t)HALF * X.ldb * ES;
    const unsigned ldsw = (unsigned)wid * 1024u;
    const int aoff = lds_byte(wr * 64 + fr, fq * 8), boff = lds_byte(wc * 32 + fr, fq * 8);

#define PG8_SA(b, h) (((b) * 2 + (h)) * HTB)
#define PG8_SB(b, h) ((4 + (b) * 2 + (h)) * HTB)
#define PG8_STAGE(bufoff, gbase, voff) do { const char* _g = (const char*)(gbase); asm volatile("" : "+s"(_g)); _Pragma("unroll") for (int _i = 0; _i < 2; ++_i) \
        __builtin_amdgcn_global_load_lds((const unsigned*)(_g + (voff)[_i]), (LAS unsigned*)(lds + (bufoff) + ldsw + _i * 8192), 16, 0, 0); } while (0)
#define PG8_LDA(dst, b, h) do { if constexpr (Src::FP8) { _Pragma("unroll") for (int m = 0; m < 4; ++m) { dst##8[m].lo = *(const LAS i32x4*)(lds + PG8_SA(b, h) + aoff + m * 2048); dst##8[m].hi = *(const LAS i32x4*)(lds + PG8_SA(b, h) + aoff + m * 2048 + 1024); } } \
        else { _Pragma("unroll") for (int m = 0; m < 4; ++m) _Pragma("unroll") for (int k = 0; k < 2; ++k) dst[m][k] = *(const LAS bf16x8*)(lds + PG8_SA(b, h) + aoff + m * 2048 + k * 1024); } } while (0)
#define PG8_LDB(dst, b, h) do { if constexpr (Src::FP8) { _Pragma("unroll") for (int n = 0; n < 2; ++n) { dst##8[n].lo = *(const LAS i32x4*)(lds + PG8_SB(b, h) + boff + n * 2048); dst##8[n].hi = *(const LAS i32x4*)(lds + PG8_SB(b, h) + boff + n * 2048 + 1024); } } \
        else { _Pragma("unroll") for (int n = 0; n < 2; ++n) _Pragma("unroll") for (int k = 0; k < 2; ++k) dst[n][k] = *(const LAS bf16x8*)(lds + PG8_SB(b, h) + boff + n * 2048 + k * 1024); } } while (0)
#define PG8_MMA(ai, bj, At, Bt) do { if constexpr (!Src::FP8) __builtin_amdgcn_s_setprio(1); _Pragma("unroll") for (int m = 0; m < 4; ++m) _Pragma("unroll") for (int n = 0; n < 2; ++n) { \
        if constexpr (Src::FP8) acc[ai][bj][m][n] = __builtin_amdgcn_mfma_scale_f32_16x16x128_f8f6f4(Bt##8[n], At##8[m], acc[ai][bj][m][n], 0, 0, 0, 0x7F7F7F7F, 0, 0x7F7F7F7F); \
        else { _Pragma("unroll") for (int k = 0; k < 2; ++k) acc[ai][bj][m][n] = __builtin_amdgcn_mfma_f32_16x16x32_bf16(Bt[n][k], At[m][k], acc[ai][bj][m][n], 0, 0, 0); } } \
        if constexpr (!Src::FP8) __builtin_amdgcn_s_setprio(0); } while (0)
#define PG8_WAIT_V(n) asm volatile("s_waitcnt vmcnt(" #n ")" ::: "memory")
#define PG8_WAIT_L(n) asm volatile("s_waitcnt lgkmcnt(" #n ")" ::: "memory")
#define PG8_WAIT_VN(n) asm volatile("s_waitcnt vmcnt(%0)" :: "n"(n) : "memory")
#define PG8_BAR __builtin_amdgcn_s_barrier()
#define PG8_SCHED __builtin_amdgcn_sched_barrier(0)
    constexpr int W1 = 8, W2 = 6;
    Unit cur, nxt; int ui = 0;
    if (!S.next(0, cur)) return;
    f32x4 acc[2][2][4][2];
#pragma unroll
    for (int a = 0; a < 2; ++a)
#pragma unroll
        for (int b = 0; b < 2; ++b)
#pragma unroll
            for (int m = 0; m < 4; ++m)
#pragma unroll
                for (int n = 0; n < 2; ++n) acc[a][b][m][n] = (f32x4){0.f, 0.f, 0.f, 0.f};
    bf16x8 At[4][2], B0[2][2], B1[2][2];
    i32x8 At8[4], B08[2], B18[2];
    unsigned cv0[2], cv1[2], nv0[2], nv1[2];
#pragma unroll
    for (int i = 0; i < 2; ++i) {
        if constexpr (Src::GATHER) { cv0[i] = (unsigned)(X.rows(cur, Rr[i]) * X.lda) * ES + 2u * Cc[i]; cv1[i] = (unsigned)(X.rows(cur, Rr[i] + HALF) * X.lda) * ES + 2u * Cc[i]; }
        else { cv0[i] = (unsigned)(Rr[i] * X.lda) * ES + 2u * Cc[i]; cv1[i] = (unsigned)((Rr[i] + HALF) * X.lda) * ES + 2u * Cc[i]; }
        nv0[i] = cv0[i]; nv1[i] = cv1[i];
    }
    const char* cA = X.a_ptr(cur); const char* cB = X.b_ptr(cur);
    PG8_STAGE(PG8_SB(0, 0), cB, voffB); PG8_STAGE(PG8_SB(0, 1), cB + hstepB, voffB); PG8_STAGE(PG8_SA(0, 0), cA, cv0); PG8_STAGE(PG8_SA(0, 1), cA, cv1);
    if (wr == 1) PG8_BAR;
    PG8_WAIT_V(2); PG8_BAR;
    PG8_STAGE(PG8_SB(1, 0), cB + kstepB, voffB); PG8_STAGE(PG8_SA(1, 0), cA + kstep, cv0); PG8_STAGE(PG8_SB(1, 1), cB + hstepB + kstepB, voffB);
    PG8_WAIT_V(6); PG8_BAR;
    for (;;) {
        const bool has_next = S.next(ui + 1, nxt);
        const char* nA = has_next ? X.a_ptr(nxt) : cA; const char* nB = has_next ? X.b_ptr(nxt) : cB;
        if constexpr (Src::GATHER) {
            if (has_next) {
#pragma unroll
                for (int i = 0; i < 2; ++i) { nv0[i] = (unsigned)(X.rows(nxt, Rr[i]) * X.lda) * ES + 2u * Cc[i]; nv1[i] = (unsigned)(X.rows(nxt, Rr[i] + HALF) * X.lda) * ES + 2u * Cc[i]; }
            } else {
#pragma unroll
                for (int i = 0; i < 2; ++i) { nv0[i] = cv0[i]; nv1[i] = cv1[i]; }
            }
        }
        for (int t = 0; t < nt; t += 2) {
            const bool last = (t == nt - 2);
            const bool full = Src::FP8 || !Sched::HALF || cur.nrows > HALF;
            const char* a1 = cA + (size_t)(t + 1) * kstep;
            const char* a2 = last ? nA : cA + (size_t)(t + 2) * kstep; const char* b2 = last ? nB : cB + (size_t)(t + 2) * kstepB;
            const char* a3 = a2 + kstep; const char* b3 = b2 + kstepB;
            unsigned w0[2], w1[2];
#pragma unroll
            for (int i = 0; i < 2; ++i) { if constexpr (Src::GATHER) { w0[i] = last ? nv0[i] : cv0[i]; w1[i] = last ? nv1[i] : cv1[i]; } else { w0[i] = cv0[i]; w1[i] = cv1[i]; } }
            PG8_LDB(B0, 0, 0); PG8_LDB(B1, 0, 1); PG8_SCHED; PG8_LDA(At, 0, 0); PG8_STAGE(PG8_SA(1, 1), a1, cv1);
            PG8_WAIT_VN(W1); PG8_WAIT_L(0); PG8_BAR; PG8_MMA(0, 0, At, B0); PG8_MMA(0, 1, At, B1); PG8_BAR; PG8_SCHED;
            if (full) PG8_LDA(At, 0, 1); PG8_STAGE(PG8_SB(0, 0), b2, voffB); PG8_STAGE(PG8_SB(0, 1), b2 + hstepB, voffB);
            PG8_WAIT_VN(W2); PG8_WAIT_L(0); PG8_BAR; if (full) { PG8_MMA(1, 0, At, B0); PG8_MMA(1, 1, At, B1); } PG8_SCHED; PG8_STAGE(PG8_SA(0, 0), a2, w0); PG8_BAR; PG8_SCHED;
            PG8_LDB(B0, 1, 0); PG8_LDB(B1, 1, 1); PG8_SCHED; PG8_LDA(At, 1, 0); PG8_STAGE(PG8_SA(0, 1), a2, w1);
            PG8_WAIT_VN(W1); PG8_WAIT_L(0); PG8_BAR; PG8_MMA(0, 0, At, B0); PG8_MMA(0, 1, At, B1); PG8_BAR; PG8_SCHED;
            if (full) PG8_LDA(At, 1, 1); PG8_STAGE(PG8_SB(1, 0), b3, voffB); PG8_STAGE(PG8_SB(1, 1), b3 + hstepB, voffB);
            PG8_WAIT_VN(W2); PG8_WAIT_L(0); PG8_BAR; if (full) { PG8_MMA(1, 0, At, B0); PG8_MMA(1, 1, At, B1); } PG8_SCHED; PG8_STAGE(PG8_SA(1, 0), a3, w0); PG8_BAR; PG8_SCHED;
        }
        if (wr == 0) PG8_BAR;
        { int tz = threadIdx.x; asm volatile("" : "+v"(tz)); const int wz = __builtin_amdgcn_readfirstlane(tz >> 6), lz = tz & 63; E(acc, cur, wz >> 2, wz & 3, lz & 15, lz >> 4); }
        if (!has_next) break;
#pragma unroll
        for (int a = 0; a < 2; ++a)
#pragma unroll
            for (int b = 0; b < 2; ++b)
#pragma unroll
                for (int m = 0; m < 4; ++m)
#pragma unroll
                    for (int n = 0; n < 2; ++n) acc[a][b][m][n] = (f32x4){0.f, 0.f, 0.f, 0.f};
        cur = nxt; cA = nA; cB = nB; ++ui;
        if constexpr (Src::GATHER) {
#pragma unroll
            for (int i = 0; i < 2; ++i) { cv0[i] = nv0[i]; cv1[i] = nv1[i]; }
        }
        if (wr == 1) PG8_BAR;
    }
    PG8_WAIT_V(0);
    PG8_BAR;
#undef PG8_SA
#undef PG8_SB
#undef PG8_STAGE
#undef PG8_LDA
#undef PG8_LDB
#undef PG8_MMA
#undef PG8_WAIT_V
#undef PG8_WAIT_L
#undef PG8_WAIT_VN
#undef PG8_BAR
#undef PG8_SCHED
}
}


template <class RowMap>
__device__ __forceinline__ void cvt_tile(const float* __restrict__ W, int N, int K, bf16* __restrict__ dst, int k0, int n0, int lane, const RowMap& rm) {
    const int kb = lane & 7, nb = lane >> 3, n = n0 + 4 * nb;
    if (n >= N) return;
    f32x4 v[8];
    const float* p = W + (size_t)(k0 + 8 * kb) * N + n;
#pragma unroll
    for (int j = 0; j < 8; ++j) v[j] = *(const f32x4*)(p + (size_t)j * N);
#pragma unroll
    for (int i = 0; i < 4; ++i) {
        u32x4 o; o.x = cvt_pk_bf16(v[0][i], v[1][i]); o.y = cvt_pk_bf16(v[2][i], v[3][i]); o.z = cvt_pk_bf16(v[4][i], v[5][i]); o.w = cvt_pk_bf16(v[6][i], v[7][i]);
        *(u32x4*)(dst + (size_t)rm(n + i) * K + k0 + 8 * kb) = o;
    }
}
struct RowId { __device__ __forceinline__ int operator()(int n) const { return n; } };
struct RowWin { __device__ __forceinline__ int operator()(int n) const { return n < 6144 ? n : (n < 6160 ? NZ + (n - 6144) : n - 16); } };
struct ZMap { int split, off0, off1; __device__ __forceinline__ int operator()(int j) const { return j + (j < split ? off0 : off1); } };
__host__ __device__ constexpr bool z_is16(int pn) { return pn >= 24 && pn < 28; }
constexpr int NZ16 = 4;
constexpr ZMap ZMAP8{24, 0, 4}, ZMAP16{0, 0, 24};
__device__ __forceinline__ void cvt_tile_win(const float* __restrict__ W, unsigned char* __restrict__ dst8, bf16* __restrict__ dst16, int k0, int n0, int lane) {
    const int kb = lane & 7, nb = lane >> 3, n = n0 + 4 * nb;
    if (n >= IN_DIM) return;
    f32x4 v[8];
    const float* p = W + (size_t)(k0 + 8 * kb) * IN_DIM + n;
#pragma unroll
    for (int j = 0; j < 8; ++j) v[j] = *(const f32x4*)(p + (size_t)j * IN_DIM);
    const int r0 = RowWin{}(n);
    if (r0 >= NZ || z_is16(r0 >> 8)) {
#pragma unroll
        for (int i = 0; i < 4; ++i) {
            u32x4 o; o.x = cvt_pk_bf16(v[0][i], v[1][i]); o.y = cvt_pk_bf16(v[2][i], v[3][i]); o.z = cvt_pk_bf16(v[4][i], v[5][i]); o.w = cvt_pk_bf16(v[6][i], v[7][i]);
            *(u32x4*)(dst16 + (size_t)(r0 + i) * D + k0 + 8 * kb) = o;
        }
    } else {
#pragma unroll
        for (int i = 0; i < 4; ++i) {
            u32x2 o; o.x = pk4_fp8(v[0][i] * W8_SCALE, v[1][i] * W8_SCALE, v[2][i] * W8_SCALE, v[3][i] * W8_SCALE); o.y = pk4_fp8(v[4][i] * W8_SCALE, v[5][i] * W8_SCALE, v[6][i] * W8_SCALE, v[7][i] * W8_SCALE);
            *(u32x2*)(dst8 + (size_t)(r0 + i) * D + k0 + 8 * kb) = o;
        }
    }
}
__device__ __forceinline__ void cvt_tile8(const float* __restrict__ W, int N, int K, unsigned char* __restrict__ dst8, int k0, int n0, int lane) {
    const int kb = lane & 7, nb = lane >> 3, n = n0 + 4 * nb;
    f32x4 v[8];
    const float* p = W + (size_t)(k0 + 8 * kb) * N + n;
#pragma unroll
    for (int j = 0; j < 8; ++j) v[j] = *(const f32x4*)(p + (size_t)j * N);
#pragma unroll
    for (int i = 0; i < 4; ++i) {
        u32x2 o; o.x = pk4_fp8(v[0][i] * W8_SCALE, v[1][i] * W8_SCALE, v[2][i] * W8_SCALE, v[3][i] * W8_SCALE); o.y = pk4_fp8(v[4][i] * W8_SCALE, v[5][i] * W8_SCALE, v[6][i] * W8_SCALE, v[7][i] * W8_SCALE);
        *(u32x2*)(dst8 + (size_t)(n + i) * K + k0 + 8 * kb) = o;
    }
}
struct RowGU { int sel; __device__ __forceinline__ int operator()(int h) const { const int pn = h >> 7, r = h & 127, wc = r >> 5, r5 = r & 31, fq = r5 >> 3, bj = (r5 >> 2) & 1, j = r5 & 3; return 256 * pn + 128 * bj + 32 * wc + 16 * sel + 4 * fq + j; } };

__device__ __forceinline__ void ph0(Frame& F) {
    const Args& a = *F.a;
    unsigned char* ws = F.ws;
    if (F.wg < 24 * KSPLIT) {
        const int jc = F.wg % 24, ks = F.wg / 24, j = jc * 512 + F.tid;
        const int kbeg = ks * KSPL, kend = (kbeg + KSPL < D) ? kbeg + KSPL : D;
        LAS float* sc = (LAS float*)F.lds;
        for (int i = F.tid; i < 4 * KSPL; i += NTHR) { const int b = i / KSPL, kk = i % KSPL; sc[i] = (kbeg + kk < D) ? siluf_(a.in[I_C][b * D + kbeg + kk]) : 0.f; }
        __syncthreads();
        float a0 = 0.f, a1 = 0.f, a2 = 0.f, a3 = 0.f;
        const float* w = a.in[I_WADA] + (size_t)kbeg * (6 * D) + j;
#pragma unroll 16
        for (int kk = 0; kk < kend - kbeg; ++kk) { const float wv = w[(size_t)kk * (6 * D)]; a0 += sc[kk] * wv; a1 += sc[KSPL + kk] * wv; a2 += sc[2 * KSPL + kk] * wv; a3 += sc[3 * KSPL + kk] * wv; }
        float* mp = (float*)(ws + WS_MODP) + (size_t)ks * 4 * (6 * D) + j;
        mp[0] = a0; mp[6 * D] = a1; mp[2 * 6 * D] = a2; mp[3 * 6 * D] = a3;
        __syncthreads();
    }
    const int gw = F.wg * NWAVES + F.wave, NGW = F.G * NWAVES;
    {
        constexpr int I_IN = 32 * 353, I_SQ = 32 * 64;
        constexpr int NITEMS = I_IN + 2 * I_SQ;
        for (int it = gw; it < NITEMS; it += NGW) {
            int r = it;
            if (r < I_IN) { cvt_tile_win(a.in[I_WIN], ws + WS_WIN8, (bf16*)(ws + WS_WIN), 64 * (r / 353), 32 * (r % 353), F.lane); continue; } r -= I_IN;
            if (r < I_SQ) { cvt_tile8(a.in[I_WA], D, D, ws + WS_WA, 64 * (r / 64), 32 * (r % 64), F.lane); continue; } r -= I_SQ;
            cvt_tile(a.in[I_WOUT], D, D, (bf16*)(ws + WS_WOUT), 64 * (r / 64), 32 * (r % 64), F.lane, RowId{});
        }
    }
    const int gt = F.wg * NTHR + F.tid, NGT = F.G * NTHR;
    for (int i = gt; i < 80 * D; i += NGT) {
        const int n = i / D, k = i % D;
        const float v = n < 8 ? a.in[I_WRG][k * 8 + n] : (n < 72 ? a.in[I_WRE][k * 64 + (n - 8)] : 0.f);
        const unsigned h = cvt_pk_bf16(v, 0.f) & 0xffffu; const float hf = __uint_as_float(h << 16);
        const unsigned l = cvt_pk_bf16(v - hf, 0.f) & 0xffffu;
        ((bf16*)(ws + WS_WRT))[i] = (bf16)h; ((bf16*)(ws + WS_WRT))[80 * D + i] = (bf16)l;
    }
    __syncthreads();
    for (int u = F.wg; u < 128; u += F.G) {
        const int g = u >> 5, n0 = (u & 31) * 64, fr = F.lane & 15, fq = F.lane >> 4;
        constexpr int WP = 528;
#pragma unroll
        for (int i = 0; i < 8; ++i) { const int d = (F.tid >> 4) + 32 * i, nn = (F.tid & 15) * 4;
            const f32x4 v = *(const f32x4*)(a.in[I_WB] + (size_t)(g * 256 + d) * D + n0 + nn);
#pragma unroll
            for (int q = 0; q < 4; ++q) *(LAS bf16*)(F.lds + (nn + q) * WP + d * 2) = (bf16)(cvt_pk_bf16(v[q], 0.f) & 0xffffu); }
        __syncthreads();
        f32x4 acc[2][4];
#pragma unroll
        for (int cb = 0; cb < 2; ++cb)
#pragma unroll
            for (int nb = 0; nb < 4; ++nb) acc[cb][nb] = (f32x4){0.f, 0.f, 0.f, 0.f};
#pragma unroll
        for (int kk = 0; kk < 8; ++kk) {
            const f32x4 p0 = *(const f32x4*)(a.in[I_PSCALE] + g * 256 + 32 * kk + 8 * fq), p1 = *(const f32x4*)(a.in[I_PSCALE] + g * 256 + 32 * kk + 8 * fq + 4);
            bf16x8 af[2];
#pragma unroll
            for (int cb = 0; cb < 2; ++cb) { const float* wp = a.in[I_WPOOL] + ((size_t)g * 256 + (2 * F.wave + cb) * 16 + fr) * 256 + 32 * kk + 8 * fq;
                const f32x4 w0 = *(const f32x4*)wp * p0, w1 = *(const f32x4*)(wp + 4) * p1;
                af[cb] = __builtin_bit_cast(bf16x8, (u32x4){cvt_pk_bf16(w0[0], w0[1]), cvt_pk_bf16(w0[2], w0[3]), cvt_pk_bf16(w1[0], w1[1]), cvt_pk_bf16(w1[2], w1[3])}); }
#pragma unroll
            for (int nb = 0; nb < 4; ++nb) { const bf16x8 bfv = *(const LAS bf16x8*)(F.lds + (nb * 16 + fr) * WP + (32 * kk + 8 * fq) * 2);
#pragma unroll
                for (int cb = 0; cb < 2; ++cb) acc[cb][nb] = __builtin_amdgcn_mfma_f32_16x16x32_bf16(af[cb], bfv, acc[cb][nb], 0, 0, 0); }
        }
#pragma unroll
        for (int cb = 0; cb < 2; ++cb)
#pragma unroll
            for (int nb = 0; nb < 4; ++nb) { u32x2 o; o.x = cvt_pk_bf16(acc[cb][nb][0], acc[cb][nb][1]); o.y = cvt_pk_bf16(acc[cb][nb][2], acc[cb][nb][3]);
                *(u32x2*)((bf16*)(ws + WS_WPB) + (size_t)(n0 + 16 * nb + fr) * 1024 + g * 256 + (2 * F.wave + cb) * 16 + 4 * fq) = o; }
        __syncthreads();
    }
}
constexpr int CW_CVT = 16384;
constexpr int CT_PITCH = 144, CT_TILE = 256 * CT_PITCH;
struct CvtItem { const float* pa; unsigned char* dst; int N, K, k0, n0, sel; };
__device__ __forceinline__ bool cvt_decode(const Args& a, unsigned char* ws, unsigned it, int wave, int lane, CvtItem& c) {
    constexpr int PER_E = 3 * 64, NITEM = NEXP * PER_E;
    if (it >= (unsigned)NITEM) return false;
    const int e = (int)it / PER_E; int r = (int)it - e * PER_E;
    const float* W;
    if (r < 128) { c.sel = r >> 6; r &= 63; W = a.in[c.sel ? I_WUP : I_WGATE] + (size_t)e * D * EH; c.dst = ws + WS_WGU + (size_t)e * 2048 * D; c.N = EH; c.K = D; c.k0 = 128 * (r >> 2); c.n0 = 256 * (r & 3); }
    else { r -= 128; c.sel = -1; W = a.in[I_WDOWN] + (size_t)e * EH * D; c.dst = ws + WS_WD + (size_t)e * D * EH; c.N = D; c.K = EH; c.k0 = 128 * (r >> 3); c.n0 = 256 * (r & 7); }
    c.pa = W + (size_t)(c.k0 + 16 * wave) * c.N + c.n0 + 4 * lane;
    return true;
}
constexpr int CW_P2DONE = 16448;
__device__ __forceinline__ void cvt_experts(Frame& F, unsigned* stopctr = nullptr, unsigned stopval = 0u) {
    const Args& a = *F.a; unsigned char* ws = F.ws;
    unsigned* ctr = (unsigned*)(ws + WS_CTL) + CW_CVT;
#define CVT_TAKE() ((stopctr && __hip_atomic_load(stopctr, RLX_AGENT) >= stopval) ? 0xFFFFFFF0u : atomicAdd(ctr, 8u))
    volatile LAS unsigned* slot = (volatile LAS unsigned*)(F.lds + LDS_MISC) + 8;
    __syncthreads();
    f32x4 va[2][16]; CvtItem ci[2]; bool ok[2];
    unsigned base; int idx = 0, par = 0;
    if (F.tid == 0) slot[0] = CVT_TAKE();
    __syncthreads();
    base = slot[0];
    if (F.tid == 0) slot[1] = CVT_TAKE();
#define CVT_GRAB(s_) do { __syncthreads(); \
        if (idx == 8) { par ^= 1; base = slot[par]; idx = 0; if (F.tid == 0) slot[par ^ 1] = CVT_TAKE(); } \
        ok[s_] = cvt_decode(a, ws, base + (unsigned)idx, F.wave, F.lane, ci[s_]); ++idx; \
        if (ok[s_]) { _Pragma("unroll") for (int j = 0; j < 16; ++j) va[s_][j] = __builtin_nontemporal_load((const f32x4*)(ci[s_].pa + (size_t)j * ci[s_].N)); } } while (0)
#define CVT_PROC(s_) do { \
        _Pragma("unroll") for (int i = 0; i < 4; ++i) { \
            u32x4 o; o.x = pk4_fp8(va[s_][0][i] * W8_SCALE, va[s_][1][i] * W8_SCALE, va[s_][2][i] * W8_SCALE, va[s_][3][i] * W8_SCALE); \
            o.y = pk4_fp8(va[s_][4][i] * W8_SCALE, va[s_][5][i] * W8_SCALE, va[s_][6][i] * W8_SCALE, va[s_][7][i] * W8_SCALE); \
            o.z = pk4_fp8(va[s_][8][i] * W8_SCALE, va[s_][9][i] * W8_SCALE, va[s_][10][i] * W8_SCALE, va[s_][11][i] * W8_SCALE); \
            o.w = pk4_fp8(va[s_][12][i] * W8_SCALE, va[s_][13][i] * W8_SCALE, va[s_][14][i] * W8_SCALE, va[s_][15][i] * W8_SCALE); \
            *(LAS u32x4*)(F.lds + (4 * F.lane + i) * CT_PITCH + F.wave * 16) = o; } \
        __syncthreads(); \
        _Pragma("unroll") for (int i = 0; i < 4; ++i) { \
            const int row = 32 * F.wave + (F.lane >> 3) + 8 * i, pc = F.lane & 7; \
            const u32x4 o = *(const LAS u32x4*)(F.lds + row * CT_PITCH + pc * 16); \
            const int ra = ci[s_].sel >= 0 ? RowGU{ci[s_].sel}(ci[s_].n0 + row) : ci[s_].n0 + row; \
            __builtin_nontemporal_store(o, (u32x4*)(ci[s_].dst + (size_t)(ra >> 8) * 256 * ci[s_].K + (size_t)(((ci[s_].k0 >> 7) * 256 + (ra & 255)) * 128 + pc * 16))); } } while (0)
    CVT_GRAB(0);
    for (;;) {
        if (!ok[0]) break;
        CVT_GRAB(1);
        CVT_PROC(0);
        if (!ok[1]) break;
        CVT_GRAB(0);
        CVT_PROC(1);
    }
#undef CVT_GRAB
#undef CVT_PROC
#undef CVT_TAKE
}

__device__ __forceinline__ float mod_sum(const float* mp, const float* bada, int b, int j) {
    float s = bada[j];
#pragma unroll
    for (int ks = 0; ks < KSPLIT; ++ks) s += mp[((size_t)ks * 4 + b) * (6 * D) + j];
    return s;
}
__device__ __forceinline__ void ph1(Frame& F) {
    const Args& a = *F.a;
    const float* mp = (const float*)(F.ws + WS_MODP);
    if (F.wg < 24) { const int j = F.wg * 512 + F.tid; float* mf = (float*)(F.ws + WS_MODF);
#pragma unroll
        for (int b = 0; b < 4; ++b) mf[b * 6 * D + j] = mod_sum(mp, a.in[I_BADA], b, j); }
    const int b = F.wg / 64;
    LAS float* gm = (LAS float*)F.lds; LAS float* sh = gm + D;
    for (int c = F.tid; c < D; c += NTHR) { gm[c] = a.in[I_NMIX][c] * (1.0f + mod_sum(mp, a.in[I_BADA], b, D + c)); sh[c] = mod_sum(mp, a.in[I_BADA], b, c); }
    __syncthreads();
    f32x4 g4[8], s4[8];
#pragma unroll
    for (int j = 0; j < 8; ++j) { g4[j] = *(const LAS f32x4*)(gm + 4 * F.lane + 256 * j); s4[j] = *(const LAS f32x4*)(sh + 4 * F.lane + 256 * j); }
    bf16* U = (bf16*)(F.ws + WS_U); unsigned char* U8 = F.ws + WS_U8;
    for (int r = 0; r < 16; ++r) {
        const int row = F.wg * 128 + F.wave * 16 + r;
        const float* src = a.in[I_X] + (size_t)row * D;
        f32x4 v[8]; float s = 0.f;
#pragma unroll
        for (int j = 0; j < 8; ++j) { v[j] = __builtin_nontemporal_load((const f32x4*)(src + 4 * F.lane + 256 * j)); s += (v[j].x * v[j].x + v[j].y * v[j].y) + (v[j].z * v[j].z + v[j].w * v[j].w); }
        const float rstd = rsqrtf(wave_sum(s) * (1.0f / D) + EPS);
#pragma unroll
        for (int j = 0; j < 8; ++j) { const f32x4 y = v[j] * rstd * g4[j] + s4[j]; u32x2 o; o.x = cvt_pk_bf16(y.x, y.y); o.y = cvt_pk_bf16(y.z, y.w);
            *(u32x2*)(U + (size_t)row * D + 4 * F.lane + 256 * j) = o;
            *(unsigned*)(U8 + (size_t)row * D + 4 * F.lane + 256 * j) = pk4_fp8(y.x, y.y, y.z, y.w); }
    }
    __syncthreads();
}

struct SrcDense {
    static constexpr bool GATHER = false, BTILED = false, FP8 = false;
    const bf16* A; const bf16* Bt; int K, lda, ldb;
    __device__ __forceinline__ const char* a_ptr(const pg8::Unit& u) const { return (const char*)(A + (size_t)u.pm * 256 * lda); }
    __device__ __forceinline__ const char* b_ptr(const pg8::Unit& u) const { return (const char*)(Bt + (size_t)u.pn * 256 * ldb); }
    __device__ __forceinline__ int rows(const pg8::Unit&, int r) const { return r; }
};
template <bool F8>
struct SrcZ {
    static constexpr bool GATHER = false, BTILED = false, FP8 = F8;
    const unsigned char* A; const unsigned char* Bt; int K, lda, ldb; ZMap zm;
    __device__ __forceinline__ const char* a_ptr(const pg8::Unit& u) const { return (const char*)(A + (size_t)u.pm * 256 * lda * (F8 ? 1 : 2)); }
    __device__ __forceinline__ const char* b_ptr(const pg8::Unit& u) const { return (const char*)(Bt + (size_t)zm(u.pn) * 256 * ldb * (F8 ? 1 : 2)); }
    __device__ __forceinline__ int rows(const pg8::Unit&, int r) const { return r; }
};
typedef const f32x4 (&AccT)[2][2][4][2];
struct EpiZ {
    static constexpr bool PERM = true;
    unsigned char* ws; ZMap zm; float sc;
    __device__ __forceinline__ void operator()(AccT acc, const pg8::Unit& u, int wr, int wc, int fr, int fq) const {
        const int row0 = u.pm * 256 + wr * 64 + fr, pn = zm(u.pn);
        size_t off; int ld, ct;
        if (pn < 4) { off = WS_Q; ld = 1024; ct = pn; } else if (pn < 8) { off = WS_K; ld = 1024; ct = pn - 4; } else if (pn < 16) { off = WS_V; ld = 2048; ct = pn - 8; }
        else if (pn < 24) { off = WS_G; ld = 2048; ct = pn - 16; } else if (pn < 28) { off = WS_P; ld = 1024; ct = pn - 24; } else if (pn < 36) { off = WS_GA; ld = 2048; ct = pn - 28; }
        else { off = WS_GB; ld = 2048; ct = pn - 36; }
        bf16* base = (bf16*)(ws + off) + ct * 256 + wc * 32 + 8 * fq;
#pragma unroll
        for (int ai = 0; ai < 2; ++ai)
#pragma unroll
            for (int m = 0; m < 4; ++m) { bf16* rowp = base + (size_t)(row0 + ai * 128 + m * 16) * ld;
#pragma unroll
                for (int bj = 0; bj < 2; ++bj) { const f32x4 v0 = acc[ai][bj][m][0] * sc, v1 = acc[ai][bj][m][1] * sc;
                    u32x4 w; w.x = cvt_pk_bf16(v0[0], v0[1]); w.y = cvt_pk_bf16(v0[2], v0[3]); w.z = cvt_pk_bf16(v1[0], v1[1]); w.w = cvt_pk_bf16(v1[2], v1[3]);
                    *(u32x4*)(rowp + bj * 128) = w; } }
    }
};
__device__ __forceinline__ void ph2(Frame& F) {
    { pg8::StaticOrder S; S.init(T, NZ - 256 * NZ16, F.G, F.wg);
      SrcZ<true> X{F.ws + WS_U8, F.ws + WS_WIN8, D, D, D, ZMAP8};
      EpiZ E{F.ws, ZMAP8, 1.0f / W8_SCALE};
      pg8::gemm_phase(F.lds, S, X, E); }
    { pg8::StaticOrder S; S.init(T, 256 * NZ16, F.G, F.wg);
      SrcZ<false> X{F.ws + WS_U, F.ws + WS_WIN, D, D, D, ZMAP16};
      EpiZ E{F.ws, ZMAP16, 1.0f};
      pg8::gemm_phase(F.lds, S, X, E); }
}


constexpr int GP_LR = 0, GP_TOT = 4096, GP_QS = 8192, GP_KS = 8192 + 33792, GP_PITCH = 528;
typedef short s16x4 __attribute__((ext_vector_type(4)));
__device__ __forceinline__ float logsig_(float x) { return fminf(x, 0.f) - __logf(1.0f + __expf(-fabsf(x))); }
__device__ __forceinline__ void gla_prep_tile(Frame& F, int tile) {
    const Args& a = *F.a;
    const int b = tile >> 7, n = tile & 127, t0 = tile * 64;
    const int cp = F.tid & 127, rq = F.tid >> 7, d0 = 2 * cp, fr = F.lane & 15, fq = F.lane >> 4;
    LAS float* lr = (LAS float*)(F.lds + GP_LR); LAS float* tot = (LAS float*)(F.lds + GP_TOT);
    bf16* Q = (bf16*)(F.ws + WS_Q); const bf16* Kp = (const bf16*)(F.ws + WS_K);
    {
        const bf16* U = (const bf16*)(F.ws + WS_U) + (size_t)(t0 + fr) * D + 256 * F.wave + 8 * fq;
        const bf16* Wl = (const bf16*)(F.ws + WS_WIN) + (size_t)(NZ + fr) * D + 256 * F.wave + 8 * fq;
        f32x4 acc[4];
#pragma unroll
        for (int rb = 0; rb < 4; ++rb) acc[rb] = (f32x4){0.f, 0.f, 0.f, 0.f};
#pragma unroll
        for (int kk = 0; kk < 8; ++kk) {
            const bf16x8 bw = *(const bf16x8*)(Wl + 32 * kk);
#pragma unroll
            for (int rb = 0; rb < 4; ++rb) { const bf16x8 au = *(const bf16x8*)(U + (size_t)rb * 16 * D + 32 * kk); acc[rb] = __builtin_amdgcn_mfma_f32_16x16x32_bf16(au, bw, acc[rb], 0, 0, 0); }
        }
        LAS f32x4* part = (LAS f32x4*)(F.lds + GP_QS);
#pragma unroll
        for (int rb = 0; rb < 4; ++rb) part[(F.wave * 4 + rb) * 64 + F.lane] = acc[rb];
        __syncthreads();
#pragma unroll
        for (int s = 0; s < 2; ++s) { const int o = 2 * F.tid + s, tk = o >> 4, col = o & 15, rb = tk >> 4, l = ((tk & 15) >> 2) * 16 + col, r = tk & 3; float v = 0.f;
#pragma unroll
            for (int w = 0; w < 8; ++w) v += ((const LAS float*)(part + (w * 4 + rb) * 64 + l))[r];
            lr[o] = v; }
        __syncthreads();
    }
    unsigned qv[16], kv[16];
#pragma unroll
    for (int ii = 0; ii < 16; ++ii) { const size_t go = (size_t)(t0 + rq * 16 + ii) * 1024 + d0; qv[ii] = *(const unsigned*)(Q + go); kv[ii] = *(const unsigned*)(Kp + go); }
#pragma unroll 1
    for (int h = 0; h < 4; ++h) {
        const int ci = (b * 4 + h) * 128 + n;
        float w2a[16], w2b[16];
#pragma unroll
        for (int r = 0; r < 16; ++r) { const f32x2 w = *(const f32x2*)(a.in[I_WGK2] + r * 1024 + h * 256 + d0); w2a[r] = w.x; w2b[r] = w.y; }
        const f32x2 b2 = *(const f32x2*)(a.in[I_BGK2] + h * 256 + d0);
        float bc0[16], bc1[16]; float cum0 = 0.f, cum1 = 0.f;
#pragma unroll
        for (int ii = 0; ii < 16; ++ii) {
            const int i = rq * 16 + ii; float g0 = b2.x, g1 = b2.y;
#pragma unroll
            for (int r4 = 0; r4 < 4; ++r4) { const f32x4 l4 = *(const LAS f32x4*)(lr + i * 16 + 4 * r4);
#pragma unroll
                for (int r = 0; r < 4; ++r) { g0 += l4[r] * w2a[4 * r4 + r]; g1 += l4[r] * w2b[4 * r4 + r]; } }
            cum0 += logsig_(g0) * (1.0f / 16.0f); cum1 += logsig_(g1) * (1.0f / 16.0f);
            bc0[ii] = cum0; bc1[ii] = cum1;
        }
        *(LAS f32x2*)(tot + rq * 256 + d0) = (f32x2){cum0, cum1};
        __syncthreads();
        float pre0 = 0.f, pre1 = 0.f, bl0 = 0.f, bl1 = 0.f;
#pragma unroll
        for (int q = 0; q < 4; ++q) { const f32x2 tq = *(const LAS f32x2*)(tot + q * 256 + d0); bl0 += tq.x; bl1 += tq.y; if (q < rq) { pre0 += tq.x; pre1 += tq.y; } }
        unsigned kd0[8], kd1[8];
#pragma unroll
        for (int ii = 0; ii < 16; ii += 2) {
            float k0v[2], k1v[2];
#pragma unroll
            for (int s = 0; s < 2; ++s) {
                const int i = rq * 16 + ii + s;
                const float bb0 = pre0 + bc0[ii + s], bb1 = pre1 + bc1[ii + s];
                const size_t go = (size_t)(t0 + i) * 1024 + h * 256 + d0;
                const unsigned qe = cvt_pk_bf16(bf_lo(qv[ii + s]) * 0.0625f * __expf(bb0), bf_hi(qv[ii + s]) * 0.0625f * __expf(bb1));
                const unsigned ke = cvt_pk_bf16(bf_lo(kv[ii + s]) * __expf(-bb0), bf_hi(kv[ii + s]) * __expf(-bb1));
                *(unsigned*)(Q + go) = qe;
                *(LAS unsigned*)(F.lds + GP_QS + i * GP_PITCH + d0 * 2) = qe;
                *(LAS unsigned*)(F.lds + GP_KS + i * GP_PITCH + d0 * 2) = ke;
                k0v[s] = bf_lo(kv[ii + s]) * __expf(bl0 - bb0); k1v[s] = bf_hi(kv[ii + s]) * __expf(bl1 - bb1);
            }
            kd0[ii >> 1] = cvt_pk_bf16(k0v[0], k0v[1]); kd1[ii >> 1] = cvt_pk_bf16(k1v[0], k1v[1]);
        }
        bf16* kdt = (bf16*)(F.ws + WS_KDT) + (size_t)ci * 16384 + rq * 16;
        *(u32x4*)(kdt + (size_t)d0 * 64) = (u32x4){kd0[0], kd0[1], kd0[2], kd0[3]}; *(u32x4*)(kdt + (size_t)d0 * 64 + 8) = (u32x4){kd0[4], kd0[5], kd0[6], kd0[7]};
        *(u32x4*)(kdt + (size_t)(d0 + 1) * 64) = (u32x4){kd1[0], kd1[1], kd1[2], kd1[3]}; *(u32x4*)(kdt + (size_t)(d0 + 1) * 64 + 8) = (u32x4){kd1[4], kd1[5], kd1[6], kd1[7]};
        if (rq == 0) *(f32x2*)((float*)(F.ws + WS_DEC) + (size_t)ci * 256 + d0) = (f32x2){__expf(bl0), __expf(bl1)};
        __syncthreads();
        const int ib = F.wave >> 1;
        bf16* att = (bf16*)(F.ws + WS_ATT) + (size_t)ci * 4096;
#pragma unroll
        for (int jj = 0; jj < 2; ++jj) {
            const int jb = 2 * (F.wave & 1) + jj;
            f32x4 acc = (f32x4){0.f, 0.f, 0.f, 0.f};
            if (jb <= ib) {
#pragma unroll
                for (int kk = 0; kk < 8; ++kk) {
                    const bf16x8 af = *(const LAS bf16x8*)(F.lds + GP_KS + (jb * 16 + fr) * GP_PITCH + (kk * 32 + 8 * fq) * 2);
                    const bf16x8 bfr = *(const LAS bf16x8*)(F.lds + GP_QS + (ib * 16 + fr) * GP_PITCH + (kk * 32 + 8 * fq) * 2);
                    acc = __builtin_amdgcn_mfma_f32_16x16x32_bf16(af, bfr, acc, 0, 0, 0);
                }
            }
            const int i = ib * 16 + fr, j0 = jb * 16 + 4 * fq;
            u32x2 o; o.x = cvt_pk_bf16(j0 <= i ? acc[0] : 0.f, j0 + 1 <= i ? acc[1] : 0.f); o.y = cvt_pk_bf16(j0 + 2 <= i ? acc[2] : 0.f, j0 + 3 <= i ? acc[3] : 0.f);
            *(u32x2*)(att + i * 64 + j0) = o;
        }
        __syncthreads();
        if (h < 3) {
#pragma unroll
            for (int ii = 0; ii < 16; ++ii) { const size_t go = (size_t)(t0 + rq * 16 + ii) * 1024 + (h + 1) * 256 + d0; qv[ii] = *(const unsigned*)(Q + go); kv[ii] = *(const unsigned*)(Kp + go); }
        }
    }
}

template <int W>
__device__ __forceinline__ void pool_item_w(Frame& F, int tile) {
    const int t0 = tile * 64, pos0 = t0 & (SEQ - 1), c = 2 * F.tid;
    const bf16* P = (const bf16*)(F.ws + WS_P) + (size_t)t0 * 1024 + c; bf16* M = (bf16*)(F.ws + WS_M) + (size_t)t0 * 1024 + c;
    unsigned prev[W - 1];
#pragma unroll
    for (int i = 0; i < W - 1; ++i) prev[i] = (pos0 > 0) ? *(const unsigned*)(P - (ptrdiff_t)(W - 1 - i) * 1024) : 0u;
    float s0 = 0.f, s1 = 0.f;
#pragma unroll
    for (int i = 0; i < W - 1; ++i) { s0 += bf_lo(prev[i]); s1 += bf_hi(prev[i]); }
#pragma unroll 1
    for (int blk = 0; blk < 4; ++blk) {
        unsigned cur[16];
#pragma unroll
        for (int t = 0; t < 16; ++t) cur[t] = *(const unsigned*)(P + (size_t)(blk * 16 + t) * 1024);
#pragma unroll
        for (int t = 0; t < 16; ++t) {
            const float c0 = bf_lo(cur[t]), c1 = bf_hi(cur[t]);
            s0 += c0; s1 += c1;
            const int pos = pos0 + blk * 16 + t;
            const float ic = (pos + 1 >= W) ? (1.0f / (float)W) : __builtin_amdgcn_rcpf((float)(pos + 1));
            *(unsigned*)(M + (size_t)(blk * 16 + t) * 1024) = cvt_pk_bf16(s0 * ic - c0, s1 * ic - c1);
            const unsigned old = (t >= W - 1) ? cur[t - (W - 1) < 0 ? 0 : t - (W - 1)] : prev[t < W - 1 ? t : 0];
            s0 -= bf_lo(old); s1 -= bf_hi(old);
        }
#pragma unroll
        for (int i = 0; i < W - 1; ++i) prev[i] = cur[16 - (W - 1) + i];
    }
}
__device__ __forceinline__ void pool_item(Frame& F, int tile) {
    const int gi = F.wave >> 1;
    if (gi == 0) pool_item_w<2>(F, tile); else if (gi == 1) pool_item_w<4>(F, tile); else if (gi == 2) pool_item_w<8>(F, tile); else pool_item_w<16>(F, tile);
}
__device__ __forceinline__ void ph3(Frame& F, int mode) {
    for (int it = F.wg; it < 512; it += F.G) pool_item(F, it);
    for (int it = F.wg; it < 512; it += F.G) gla_prep_tile(F, it);
}


constexpr int GS_QP = 272, GS_KTP = 144, GS_ATP = 144;
constexpr int GS_QS = 0, GS_KT = GS_QS + 64 * GS_QP, GS_ATT = GS_KT + 128 * GS_KTP, GS_DEC = GS_ATT + 32 * GS_ATP, GS_VS = GS_DEC + 512, GS_STAGE = GS_VS + 8 * 2048;
static_assert(2 * GS_STAGE <= RING_BYTES && GS_STAGE % 16 == 0, "scan LDS");
struct ScanRegs { u32x4 pq[2], pk[2], pv[2], pa; };
__device__ __forceinline__ void gla_scan_unit(Frame& F, int unit) {
    const int kh = unit & 1, dvq = (unit >> 1) & 3, bh = unit >> 3, h = bh & 3, b = bh >> 2;
    const int fr = F.lane & 15, fq = F.lane >> 4, dvh = dvq * 128 + F.wave * 16;
    const bf16* Q = (const bf16*)(F.ws + WS_Q); const bf16* KDT = (const bf16*)(F.ws + WS_KDT); const bf16* ATT = (const bf16*)(F.ws + WS_ATT);
    const float* DEC = (const float*)(F.ws + WS_DEC); const bf16* V = (const bf16*)(F.ws + WS_V);
    bf16* Ob = kh == 0 ? (bf16*)(F.ws + WS_O) + h * 512 + dvh : (bf16*)(F.ws + (h < 2 ? WS_K : WS_P)) + (h & 1) * 512 + dvh;
    const int Old = kh == 0 ? 2048 : 1024;
    u32x4 Sb[4];
#pragma unroll
    for (int t = 0; t < 4; ++t) Sb[t] = (u32x4){0u, 0u, 0u, 0u};
    ScanRegs R0, R1;
    const unsigned qoff0 = (unsigned)((F.tid >> 4) * 1024 + (F.tid & 15) * 8) * 2u, qoff1 = qoff0 + 32u * 1024u * 2u;
    const unsigned koff = (unsigned)F.tid * 16u, voff = (unsigned)F.lane * 4096u;
    const unsigned lq0 = (unsigned)((F.tid >> 4) * GS_QP + (F.tid & 15) * 16), lq1 = lq0 + 32u * GS_QP;
    const unsigned lk0 = (unsigned)((F.tid >> 3) * GS_KTP + (F.tid & 7) * 16), lk1 = lk0 + 64u * GS_KTP;
    const unsigned la = F.tid < 256 ? (unsigned)(GS_ATT + (F.tid >> 3) * GS_ATP + (F.tid & 7) * 16) : (unsigned)(GS_DEC + (F.tid - 256) * 16);
#define GS_LOAD(R, n_) do { const int ci_ = bh * 128 + (n_); const size_t t0_ = (size_t)b * SEQ + (size_t)(n_) * 64; \
        const char* qn_ = (const char*)(Q + t0_ * 1024 + h * 256 + kh * 128); const char* kn_ = (const char*)(KDT + (size_t)ci_ * 16384 + kh * 8192); \
        R.pq[0] = *(const u32x4*)(qn_ + qoff0); R.pq[1] = *(const u32x4*)(qn_ + qoff1); R.pk[0] = *(const u32x4*)(kn_ + koff); R.pk[1] = *(const u32x4*)(kn_ + koff + 8192); \
        const char* vn_ = (const char*)(V + t0_ * 2048 + h * 512 + dvh); R.pv[0] = *(const u32x4*)(vn_ + voff); R.pv[1] = *(const u32x4*)(vn_ + voff + 16); \
        if (F.tid < 256) R.pa = *(const u32x4*)((const char*)(ATT + (size_t)ci_ * 4096 + kh * 2048) + koff); \
        else if (F.tid < 288) R.pa = *(const u32x4*)((const char*)(DEC + (size_t)ci_ * 256 + kh * 128) + (koff - 4096u)); } while (0)
#define GS_STORE(R, st_) do { LAS unsigned char* sb_ = F.lds + (st_) * GS_STAGE; \
        *(LAS u32x4*)(sb_ + GS_QS + lq0) = R.pq[0]; *(LAS u32x4*)(sb_ + GS_QS + lq1) = R.pq[1]; *(LAS u32x4*)(sb_ + GS_KT + lk0) = R.pk[0]; *(LAS u32x4*)(sb_ + GS_KT + lk1) = R.pk[1]; \
        *(LAS u32x4*)(sb_ + GS_VS + F.wave * 2048 + F.lane * 32) = R.pv[0]; *(LAS u32x4*)(sb_ + GS_VS + F.wave * 2048 + F.lane * 32 + 16) = R.pv[1]; \
        if (F.tid < 288) *(LAS u32x4*)(sb_ + la) = R.pa; } while (0)
#define GS_STEP(n_, RL, RS) do { \
        const size_t t0 = (size_t)b * SEQ + (size_t)(n_) * 64; \
        const LAS unsigned char* sb = F.lds + ((n_) & 1) * GS_STAGE; \
        if ((n_) + 2 < 128) GS_LOAD(RL, (n_) + 2); \
        const LAS unsigned char* vs = sb + GS_VS + F.wave * 2048; \
        bf16x8 vf[2]; \
        _Pragma("unroll") for (int ks = 0; ks < 2; ++ks) { const int q = (F.lane & 15) >> 2, p = F.lane & 3; \
            const s16x4 lo = __builtin_amdgcn_ds_read_tr16_b64_v4i16((LAS s16x4*)(vs + (32 * ks + 8 * fq + q) * 32 + p * 8)); \
            const s16x4 hi = __builtin_amdgcn_ds_read_tr16_b64_v4i16((LAS s16x4*)(vs + (32 * ks + 8 * fq + 4 + q) * 32 + p * 8)); \
            vf[ks] = (bf16x8){lo[0], lo[1], lo[2], lo[3], hi[0], hi[1], hi[2], hi[3]}; } \
        f32x4 oacc[4]; \
        _Pragma("unroll") for (int tb = 0; tb < 4; ++tb) oacc[tb] = (f32x4){0.f, 0.f, 0.f, 0.f}; \
        _Pragma("unroll") for (int kb = 0; kb < 4; ++kb) { \
            const u32x4 sfw = Sb[kb]; const bf16x8 sf = __builtin_bit_cast(bf16x8, sfw); \
            bf16x8 qf[4]; \
            _Pragma("unroll") for (int tb = 0; tb < 4; ++tb) { const LAS unsigned char* qp = sb + GS_QS + (tb * 16 + fr) * GS_QP + kb * 64 + fq * 8; \
                const u32x2 qa = *(const LAS u32x2*)qp, qb = *(const LAS u32x2*)(qp + 32); qf[tb] = __builtin_bit_cast(bf16x8, (u32x4){qa.x, qa.y, qb.x, qb.y}); } \
            bf16x8 kf[2][2]; f32x4 dc[2]; \
            _Pragma("unroll") for (int tt = 0; tt < 2; ++tt) { dc[tt] = *(const LAS f32x4*)(sb + GS_DEC + (2 * kb + tt) * 64 + fq * 16); \
                _Pragma("unroll") for (int ks = 0; ks < 2; ++ks) kf[tt][ks] = *(const LAS bf16x8*)(sb + GS_KT + ((2 * kb + tt) * 16 + fr) * GS_KTP + ks * 64 + fq * 16); } \
            _Pragma("unroll") for (int tb = 0; tb < 4; ++tb) oacc[tb] = __builtin_amdgcn_mfma_f32_16x16x32_bf16(sf, qf[tb], oacc[tb], 0, 0, 0); \
            f32x4 s0 = (f32x4){bf_lo(sfw.x), bf_hi(sfw.x), bf_lo(sfw.y), bf_hi(sfw.y)} * dc[0], s1 = (f32x4){bf_lo(sfw.z), bf_hi(sfw.z), bf_lo(sfw.w), bf_hi(sfw.w)} * dc[1]; \
            s0 = __builtin_amdgcn_mfma_f32_16x16x32_bf16(kf[0][0], vf[0], s0, 0, 0, 0); s1 = __builtin_amdgcn_mfma_f32_16x16x32_bf16(kf[1][0], vf[0], s1, 0, 0, 0); \
            s0 = __builtin_amdgcn_mfma_f32_16x16x32_bf16(kf[0][1], vf[1], s0, 0, 0, 0); s1 = __builtin_amdgcn_mfma_f32_16x16x32_bf16(kf[1][1], vf[1], s1, 0, 0, 0); \
            Sb[kb] = (u32x4){cvt_pk_bf16(s0[0], s0[1]), cvt_pk_bf16(s0[2], s0[3]), cvt_pk_bf16(s1[0], s1[1]), cvt_pk_bf16(s1[2], s1[3])}; \
        } \
        _Pragma("unroll") for (int t2 = 0; t2 < 2; ++t2) {        \
            const bf16x8 a0 = *(const LAS bf16x8*)(sb + GS_ATT + (t2 * 16 + fr) * GS_ATP + fq * 16), a1 = *(const LAS bf16x8*)(sb + GS_ATT + (t2 * 16 + fr) * GS_ATP + 64 + fq * 16); \
            f32x4 oo = kh == 0 ? oacc[t2] : oacc[2 + t2]; \
            oo = __builtin_amdgcn_mfma_f32_16x16x32_bf16(vf[0], a0, oo, 0, 0, 0); oo = __builtin_amdgcn_mfma_f32_16x16x32_bf16(vf[1], a1, oo, 0, 0, 0); \
            if (kh == 0) oacc[t2] = oo; else oacc[2 + t2] = oo; } \
        _Pragma("unroll") for (int tb = 0; tb < 4; ++tb) { u32x2 o; o.x = cvt_pk_bf16(oacc[tb][0], oacc[tb][1]); o.y = cvt_pk_bf16(oacc[tb][2], oacc[tb][3]); \
            *(u32x2*)(Ob + (t0 + 16 * tb + fr) * Old + 4 * fq) = o; } \
        if ((n_) + 1 < 128) GS_STORE(RS, ((n_) + 1) & 1); \
        __syncthreads(); } while (0)
    GS_LOAD(R0, 0); GS_LOAD(R1, 1);
    GS_STORE(R0, 0);
    __syncthreads();
#pragma unroll 1
    for (int n = 0; n < 128; n += 2) {
        GS_STEP(n, R0, R1);
        GS_STEP(n + 1, R1, R0);
    }
#undef GS_LOAD
#undef GS_STORE
#undef GS_STEP
}

__device__ __forceinline__ void ph5(Frame& F) {
    const Args& a = *F.a;
    bf16* O = (bf16*)(F.ws + WS_O); const bf16* Gp = (const bf16*)(F.ws + WS_G);
    const f32x4 gn0 = *(const f32x4*)(a.in[I_GLAN] + 8 * F.lane), gn1 = *(const f32x4*)(a.in[I_GLAN] + 8 * F.lane + 4);
    const float gn[8] = {gn0.x, gn0.y, gn0.z, gn0.w, gn1.x, gn1.y, gn1.z, gn1.w};
    for (int r = 0; r < 16; ++r) {
        const size_t row = (size_t)F.wg * 128 + F.wave * 16 + r;
#pragma unroll
        for (int j = 0; j < 4; ++j) {
            const size_t off = row * 2048 + 512 * j + 8 * F.lane;
            const u32x4 ov = __builtin_nontemporal_load((const u32x4*)(O + off)), gv = __builtin_nontemporal_load((const u32x4*)(Gp + off));
            const u32x4 o1 = __builtin_nontemporal_load((const u32x4*)((const bf16*)(F.ws + (j < 2 ? WS_K : WS_P)) + row * 1024 + (j & 1) * 512 + 8 * F.lane));
            float o[8] = {bf_lo(ov.x) + bf_lo(o1.x), bf_hi(ov.x) + bf_hi(o1.x), bf_lo(ov.y) + bf_lo(o1.y), bf_hi(ov.y) + bf_hi(o1.y), bf_lo(ov.z) + bf_lo(o1.z), bf_hi(ov.z) + bf_hi(o1.z), bf_lo(ov.w) + bf_lo(o1.w), bf_hi(ov.w) + bf_hi(o1.w)};
            const float g[8] = {bf_lo(gv.x), bf_hi(gv.x), bf_lo(gv.y), bf_hi(gv.y), bf_lo(gv.z), bf_hi(gv.z), bf_lo(gv.w), bf_hi(gv.w)};
            float s = 0.f;
#pragma unroll
            for (int q = 0; q < 8; ++q) s += o[q] * o[q];
            const float rstd = rsqrtf(wave_sum(s) * (1.0f / 512.0f) + EPS);
#pragma unroll
            for (int q = 0; q < 8; ++q) o[q] = o[q] * rstd * gn[q] * siluf_(g[q]);
            *(u32x2*)(F.ws + WS_U8 + off) = (u32x2){pk4_fp8(o[0], o[1], o[2], o[3]), pk4_fp8(o[4], o[5], o[6], o[7])};
        }
    }
}

struct EpiPool {
    static constexpr bool PERM = true;
    unsigned char* ws;
    __device__ __forceinline__ void operator()(AccT acc, const pg8::Unit& u, int wr, int wc, int fr, int fq) const {
        const int row0 = u.pm * 256 + wr * 64 + fr;
        const size_t cb = u.pn * 256 + wc * 32 + 8 * fq;
#pragma unroll
        for (int ai = 0; ai < 2; ++ai) {
            u32x4 gq[4][2];
#pragma unroll
            for (int m = 0; m < 4; ++m) { const size_t ro = (size_t)(row0 + ai * 128 + m * 16) * D + cb;
#pragma unroll
                for (int bj = 0; bj < 2; ++bj) gq[m][bj] = __builtin_nontemporal_load((const u32x4*)((const bf16*)(ws + WS_GB) + ro + bj * 128)); }
#pragma unroll
            for (int m = 0; m < 4; ++m) { const size_t ro = (size_t)(row0 + ai * 128 + m * 16) * D + cb;
#pragma unroll
                for (int bj = 0; bj < 2; ++bj) { const f32x4 v0 = acc[ai][bj][m][0], v1 = acc[ai][bj][m][1]; const u32x4 g = gq[m][bj];
                    u32x4 w; w.x = cvt_pk_bf16(v0[0] * sigmoidf_(bf_lo(g.x)), v0[1] * sigmoidf_(bf_hi(g.x))); w.y = cvt_pk_bf16(v0[2] * sigmoidf_(bf_lo(g.y)), v0[3] * sigmoidf_(bf_hi(g.y)));
                    w.z = cvt_pk_bf16(v1[0] * sigmoidf_(bf_lo(g.z)), v1[1] * sigmoidf_(bf_hi(g.z))); w.w = cvt_pk_bf16(v1[2] * sigmoidf_(bf_lo(g.w)), v1[3] * sigmoidf_(bf_hi(g.w)));
                    *(u32x4*)((bf16*)(ws + WS_U) + ro + bj * 128) = w; } }
        }
    }
};
struct EpiMergeA {
    static constexpr bool PERM = true;
    unsigned char* ws;
    __device__ __forceinline__ void operator()(AccT acc, const pg8::Unit& u, int wr, int wc, int fr, int fq) const {
        const int row0 = u.pm * 256 + wr * 64 + fr;
        const size_t cb = u.pn * 256 + wc * 32 + 8 * fq;
#pragma unroll
        for (int ai = 0; ai < 2; ++ai) {
            u32x4 gq[4][2], yq[4][2];
#pragma unroll
            for (int m = 0; m < 4; ++m) { const size_t ro = (size_t)(row0 + ai * 128 + m * 16) * D + cb;
#pragma unroll
                for (int bj = 0; bj < 2; ++bj) { gq[m][bj] = __builtin_nontemporal_load((const u32x4*)((const bf16*)(ws + WS_GA) + ro + bj * 128)); yq[m][bj] = *(const u32x4*)((const bf16*)(ws + WS_U) + ro + bj * 128); } }
#pragma unroll
            for (int m = 0; m < 4; ++m) { const size_t ro = (size_t)(row0 + ai * 128 + m * 16) * D + cb;
#pragma unroll
                for (int bj = 0; bj < 2; ++bj) { const f32x4 v0 = acc[ai][bj][m][0] * (1.0f / W8_SCALE), v1 = acc[ai][bj][m][1] * (1.0f / W8_SCALE); const u32x4 g = gq[m][bj], y = yq[m][bj];
                    u32x4 w; w.x = cvt_pk_bf16(bf_lo(y.x) + v0[0] * sigmoidf_(bf_lo(g.x)), bf_hi(y.x) + v0[1] * sigmoidf_(bf_hi(g.x)));
                    w.y = cvt_pk_bf16(bf_lo(y.y) + v0[2] * sigmoidf_(bf_lo(g.y)), bf_hi(y.y) + v0[3] * sigmoidf_(bf_hi(g.y)));
                    w.z = cvt_pk_bf16(bf_lo(y.z) + v1[0] * sigmoidf_(bf_lo(g.z)), bf_hi(y.z) + v1[1] * sigmoidf_(bf_hi(g.z)));
                    w.w = cvt_pk_bf16(bf_lo(y.w) + v1[2] * sigmoidf_(bf_lo(g.w)), bf_hi(y.w) + v1[3] * sigmoidf_(bf_hi(g.w)));
                    *(u32x4*)((bf16*)(ws + WS_U) + ro + bj * 128) = w; } }
        }
    }
};
struct EpiH1 {
    static constexpr bool PERM = false;
    const float* x; bf16* out; const float* modf; float* rss;
    __device__ __forceinline__ void operator()(AccT acc, const pg8::Unit& u, int wr, int wc, int fr, int fq) const {
        const int row0 = u.pm * 256 + wr * 64 + fr, col0 = u.pn * 256 + wc * 32 + 4 * fq;
        const float* g1 = modf + (size_t)(u.pm >> 5) * (6 * D) + 2 * D + col0;
        f32x4 gv[2][2];
#pragma unroll
        for (int bj = 0; bj < 2; ++bj)
#pragma unroll
            for (int n = 0; n < 2; ++n) gv[bj][n] = *(const f32x4*)(g1 + bj * 128 + n * 16);
#pragma unroll
        for (int ai = 0; ai < 2; ++ai) {
            f32x4 xv[4][2][2];
#pragma unroll
            for (int m = 0; m < 4; ++m) { const size_t ro = (size_t)(row0 + ai * 128 + m * 16) * D + col0;
#pragma unroll
                for (int bj = 0; bj < 2; ++bj)
#pragma unroll
                    for (int n = 0; n < 2; ++n) xv[m][bj][n] = __builtin_nontemporal_load((const f32x4*)(x + ro + bj * 128 + n * 16)); }
#pragma unroll
            for (int m = 0; m < 4; ++m) { const size_t ro = (size_t)(row0 + ai * 128 + m * 16) * D + col0;
                float ss = 0.f;
#pragma unroll
                for (int bj = 0; bj < 2; ++bj)
#pragma unroll
                    for (int n = 0; n < 2; ++n) { const f32x4 hv = xv[m][bj][n] + gv[bj][n] * acc[ai][bj][m][n];
                        *(u32x2*)(out + ro + bj * 128 + n * 16) = (u32x2){cvt_pk_bf16(hv.x, hv.y), cvt_pk_bf16(hv.z, hv.w)}; ss += (hv.x * hv.x + hv.y * hv.y) + (hv.z * hv.z + hv.w * hv.w); }
                ss += __shfl_xor(ss, 16); ss += __shfl_xor(ss, 32);
                if (fq == 0) rss[(size_t)(row0 + ai * 128 + m * 16) * 32 + u.pn * 4 + wc] = ss; }
        }
    }
};
__device__ __forceinline__ void ph6(Frame& F) {
    pg8::StaticOrder S; S.init(T, D, F.G, F.wg);
    SrcZ<true> X{F.ws + WS_U8, F.ws + WS_WA, D, D, D, ZMap{0, 0, 0}};
    EpiMergeA E{F.ws};
    pg8::gemm_phase(F.lds, S, X, E);
}
__device__ __forceinline__ void pool_gemm(Frame& F, int rank, int nwg, int off, int lim) {
    pg8::StaticOrder S; S.init(T, D, nwg, rank); S.off = off; S.lim = lim;
    SrcDense X{(const bf16*)(F.ws + WS_M), (const bf16*)(F.ws + WS_WPB), 1024, 1024, 1024};
    EpiPool E{F.ws};
    pg8::gemm_phase(F.lds, S, X, E);
}
__device__ __forceinline__ void ph4(Frame& F) {
    constexpr int POOL_A = 640, NPOOLWG = 50;
    if (F.wg < 128) { const int x = F.wg & 7, j = F.wg >> 3; gla_scan_unit(F, (2 * x + (j >> 3)) * 8 + (j & 7)); __syncthreads(); pool_gemm(F, F.wg, 128, POOL_A, 1024); }
    else if (F.wg >= 256 - NPOOLWG) pool_gemm(F, F.wg - (256 - NPOOLWG), NPOOLWG, 0, POOL_A);
    cvt_experts(F);
}
__device__ __forceinline__ void ph8(Frame& F) {
    pg8::StaticOrder S; S.init(T, D, F.G, F.wg);
    SrcDense X{(const bf16*)(F.ws + WS_U), (const bf16*)(F.ws + WS_WOUT), D, D, D};
    EpiH1 E{F.a->in[I_X], (bf16*)(F.ws + WS_H1), (const float*)(F.ws + WS_MODF), (float*)(F.ws + WS_RSS)};
    pg8::gemm_phase(F.lds, S, X, E);
}


constexpr int MISC_TB = 16, MISC_CNT = 96;
__device__ __forceinline__ void ph9(Frame& F) {
    const Args& a = *F.a;
    const int b = F.wg / 64, fr = F.lane & 15, fq = F.lane >> 4;
    const float* mf = (const float*)(F.ws + WS_MODF) + (size_t)b * 6 * D;
    constexpr int BST = 16384, BPITCH = 272, BHL = 80 * BPITCH, BSTAGE = 2 * BHL;
    LAS float* gm = (LAS float*)F.lds; LAS float* sh = gm + D; LAS float* lg = (LAS float*)(F.lds + BST) + F.wave * (16 * 80);
    for (int c = F.tid; c < D; c += NTHR) { gm[c] = a.in[I_NFFN][c] * (1.0f + mf[4 * D + c]); sh[c] = mf[3 * D + c]; }
    const int r0 = F.wg * 128 + F.wave * 16;
    float myrstd;
    { const float* rs = (const float*)(F.ws + WS_RSS) + (size_t)(r0 + fr) * 32; float s = 0.f;
#pragma unroll
      for (int q = 0; q < 8; ++q) { const f32x4 p = *(const f32x4*)(rs + 4 * q); s += (p.x + p.y) + (p.z + p.w); }
      myrstd = rsqrtf(s * (1.0f / D) + EPS); }
    f32x4 acc[5];
#pragma unroll
    for (int nb = 0; nb < 5; ++nb) acc[nb] = (f32x4){0.f, 0.f, 0.f, 0.f};
    const bf16* hrow = (const bf16*)(F.ws + WS_H1) + (size_t)(r0 + fr) * D + 8 * fq;
    unsigned char* U2 = (unsigned char*)(F.ws + WS_U) + (size_t)(r0 + fr) * D + 8 * fq;
    const bf16* W = (const bf16*)(F.ws + WS_WRT);
    u32x4 pb[5]; u32x4 xc[4], xn[4];
#define P9_LOADB(s_) do { _Pragma("unroll") for (int j = 0; j < 5; ++j) { const int p = F.tid + 512 * j, hl = p / 1280, rem = p - hl * 1280; \
        pb[j] = *(const u32x4*)(W + (size_t)hl * 80 * D + (size_t)(rem >> 4) * D + (s_) * 128 + (rem & 15) * 8); } } while (0)
#define P9_STOREB(st_) do { _Pragma("unroll") for (int j = 0; j < 5; ++j) { const int p = F.tid + 512 * j, hl = p / 1280, rem = p - hl * 1280; \
        *(LAS u32x4*)(F.lds + BST + (st_) * BSTAGE + hl * BHL + (rem >> 4) * BPITCH + (rem & 15) * 16) = pb[j]; } } while (0)
#define P9_LOADX(dst_, s_) do { _Pragma("unroll") for (int k4 = 0; k4 < 4; ++k4) dst_[k4] = *(const u32x4*)(hrow + (s_) * 128 + 32 * k4); } while (0)
    P9_LOADB(0); P9_LOADX(xc, 0);
    P9_STOREB(0);
    __syncthreads();
    for (int s = 0; s < 16; ++s) {
        if (s + 1 < 16) { P9_LOADB(s + 1); P9_LOADX(xn, s + 1); }
        const LAS unsigned char* Bs = F.lds + BST + (s & 1) * BSTAGE;
#pragma unroll
        for (int k4 = 0; k4 < 4; ++k4) {
            const int c0 = s * 128 + 32 * k4 + 8 * fq;
            const f32x4 g0 = *(const LAS f32x4*)(gm + c0), g1 = *(const LAS f32x4*)(gm + c0 + 4), s0 = *(const LAS f32x4*)(sh + c0), s1 = *(const LAS f32x4*)(sh + c0 + 4);
            const u32x4 xr = xc[k4]; const f32x4 x0 = (f32x4){bf_lo(xr.x), bf_hi(xr.x), bf_lo(xr.y), bf_hi(xr.y)}, x1 = (f32x4){bf_lo(xr.z), bf_hi(xr.z), bf_lo(xr.w), bf_hi(xr.w)};
            const f32x4 u0 = x0 * myrstd * g0 + s0, u1 = x1 * myrstd * g1 + s1;
            u32x4 hw; hw.x = cvt_pk_bf16(u0[0], u0[1]); hw.y = cvt_pk_bf16(u0[2], u0[3]); hw.z = cvt_pk_bf16(u1[0], u1[1]); hw.w = cvt_pk_bf16(u1[2], u1[3]);
            u32x4 lw; lw.x = cvt_pk_bf16(u0[0] - bf_lo(hw.x), u0[1] - bf_hi(hw.x)); lw.y = cvt_pk_bf16(u0[2] - bf_lo(hw.y), u0[3] - bf_hi(hw.y));
            lw.z = cvt_pk_bf16(u1[0] - bf_lo(hw.z), u1[1] - bf_hi(hw.z)); lw.w = cvt_pk_bf16(u1[2] - bf_lo(hw.w), u1[3] - bf_hi(hw.w));
            *(u32x2*)(U2 + s * 128 + 32 * k4) = (u32x2){pk4_fp8(u0[0], u0[1], u0[2], u0[3]), pk4_fp8(u1[0], u1[1], u1[2], u1[3])};
            const bf16x8 ah = __builtin_bit_cast(bf16x8, hw), al = __builtin_bit_cast(bf16x8, lw);
#pragma unroll
            for (int nb = 0; nb < 5; ++nb) {
                const bf16x8 bh = *(const LAS bf16x8*)(Bs + (nb * 16 + fr) * BPITCH + (32 * k4 + 8 * fq) * 2), bl = *(const LAS bf16x8*)(Bs + BHL + (nb * 16 + fr) * BPITCH + (32 * k4 + 8 * fq) * 2);
                acc[nb] = __builtin_amdgcn_mfma_f32_16x16x32_bf16(ah, bh, acc[nb], 0, 0, 0);
                acc[nb] = __builtin_amdgcn_mfma_f32_16x16x32_bf16(al, bh, acc[nb], 0, 0, 0);
                acc[nb] = __builtin_amdgcn_mfma_f32_16x16x32_bf16(ah, bl, acc[nb], 0, 0, 0);
            }
        }
        if (s + 1 < 16) { P9_STOREB((s + 1) & 1);
#pragma unroll
            for (int q = 0; q < 4; ++q) xc[q] = xn[q]; }
        __syncthreads();
    }
#undef P9_LOADB
#undef P9_STOREB
#undef P9_LOADX
#pragma unroll
    for (int nb = 0; nb < 5; ++nb)
#pragma unroll
        for (int r = 0; r < 4; ++r) lg[(4 * fq + r) * 80 + 16 * nb + fr] = acc[nb][r];
    __syncthreads();
    if (F.lane < 16) {
        const int tok = r0 + F.lane; const LAS float* L = lg + F.lane * 80;
        float gl[8]; float gmax = -3.0e38f; int gsel = 0;
#pragma unroll
        for (int j = 0; j < 8; ++j) { gl[j] = L[j] + a.in[I_BRG][j]; if (gl[j] > gmax) { gmax = gl[j]; gsel = j; } }
        float gs = 0.f;
#pragma unroll
        for (int j = 0; j < 8; ++j) gs += __expf(gl[j] - gmax);
        const float pg = 1.0f / gs;
        float v0 = -3.0e38f, v1 = -3.0e38f; int i0 = 0, i1 = 0;
#pragma unroll
        for (int j = 0; j < 8; ++j) {
            const float e = L[8 + gsel * 8 + j] + a.in[I_BRE][gsel * 8 + j];
            if (e > v0) { v1 = v0; i1 = i0; v0 = e; i0 = j; } else if (e > v1) { v1 = e; i1 = j; }
        }
        const float w0 = 1.0f / (1.0f + __expf(v1 - v0)), w1 = 1.0f - w0;
        const int e0 = gsel * 8 + i0, e1 = gsel * 8 + i1;
        unsigned* cnt = (unsigned*)(F.ws + WS_CTL) + CW_CNT;
        const int p0 = (int)atomicAdd(cnt + 64 * e0, 1u), p1 = (int)atomicAdd(cnt + 64 * e1, 1u);
        int* list = (int*)(F.ws + WS_LIST);
        list[(size_t)e0 * T + p0] = tok; list[(size_t)e1 * T + p1] = tok;
        ((int4*)(F.ws + WS_ASG))[tok] = make_int4(e0, p0, e1, p1);
        ((f32x2*)(F.ws + WS_ASGW))[tok] = (f32x2){pg * w0, pg * w1};
    }
    __syncthreads();
}

constexpr int MISC_NFH = 12;
constexpr int LDS_TL = LDS_MISC + 1024;
__device__ __forceinline__ void build_tiles(Frame& F) {
    volatile LAS int* misc = (volatile LAS int*)(F.lds + LDS_MISC);
    volatile LAS int* fl = (volatile LAS int*)(F.lds + LDS_TL); volatile LAS int* hl = fl + 320;
    if (F.tid < 64) {
        unsigned* cnt = (unsigned*)(F.ws + WS_CTL) + CW_CNT;
        const int c = (int)__hip_atomic_load(cnt + 64 * F.tid, RLX_AGENT);
        const int nt = (c + 255) >> 8, half = (nt > 0 && c - (nt - 1) * 256 <= 128) ? 1 : 0, full = nt - half;
        int inc = nt, fin = full, hin = half;
#pragma unroll
        for (int o = 1; o < 64; o <<= 1) { const int t = __shfl_up(inc, o), tf = __shfl_up(fin, o), th = __shfl_up(hin, o); if (F.lane >= o) { inc += t; fin += tf; hin += th; } }
        const int t0 = inc - nt, f0 = fin - full, h0 = hin - half;
        misc[MISC_TB + F.tid] = t0; misc[MISC_CNT + F.tid] = c;
        if (F.tid == 63) { misc[MISC_TB + 64] = inc; misc[MISC_NFH] = fin; misc[MISC_NFH + 1] = hin; }
        for (int j = 0; j < full; ++j) fl[f0 + j] = t0 + j;
        if (half) hl[h0] = t0 + nt - 1;
    }
    __syncthreads();
}

struct SrcGU {
    static constexpr bool GATHER = true, BTILED = true, FP8 = true;
    const unsigned char* A; const unsigned char* Bt; const int* list; const volatile LAS int* cnt; int K, lda, ldb;
    __device__ __forceinline__ const char* a_ptr(const pg8::Unit&) const { return (const char*)A; }
    __device__ __forceinline__ const char* b_ptr(const pg8::Unit& u) const { return (const char*)(Bt + ((size_t)u.e * 2048 + (size_t)u.pn * 256) * ldb); }
    __device__ __forceinline__ int rows(const pg8::Unit& u, int r) const { const int i = u.r0 + r; return i < cnt[u.e] ? list[(size_t)u.e * T + i] : 0; }
};
struct SrcDown {
    static constexpr bool GATHER = false, BTILED = true, FP8 = true;
    const unsigned char* A; const unsigned char* Bt; int K, lda, ldb;
    __device__ __forceinline__ const char* a_ptr(const pg8::Unit& u) const { return (const char*)(A + (size_t)u.pm * 256 * lda); }
    __device__ __forceinline__ const char* b_ptr(const pg8::Unit& u) const { return (const char*)(Bt + ((size_t)u.e * 2048 + (size_t)u.pn * 256) * ldb); }
    __device__ __forceinline__ int rows(const pg8::Unit&, int r) const { return r; }
};
struct EpiHid {
    static constexpr bool PERM = false;
    unsigned char* H;
    __device__ __forceinline__ void operator()(AccT acc, const pg8::Unit& u, int wr, int wc, int fr, int fq) const {
        unsigned char* base = H + (size_t)(u.pm * 256 + wr * 64 + fr) * EH + u.pn * 128 + wc * 32 + 8 * fq;
        constexpr float IS = 1.0f / W8_SCALE, OS = H8_SCALE / W8_SCALE;
#pragma unroll
        for (int ai = 0; ai < 2; ++ai)
#pragma unroll
            for (int m = 0; m < 4; ++m) {
                const f32x4 g0 = acc[ai][0][m][0] * IS, u0 = acc[ai][0][m][1] * OS, g1 = acc[ai][1][m][0] * IS, u1 = acc[ai][1][m][1] * OS;
                u32x2 w; w.x = pk4_fp8(sat8(siluf_(g0[0]) * u0[0]), sat8(siluf_(g0[1]) * u0[1]), sat8(siluf_(g0[2]) * u0[2]), sat8(siluf_(g0[3]) * u0[3]));
                w.y = pk4_fp8(sat8(siluf_(g1[0]) * u1[0]), sat8(siluf_(g1[1]) * u1[1]), sat8(siluf_(g1[2]) * u1[2]), sat8(siluf_(g1[3]) * u1[3]));
                *(u32x2*)(base + (size_t)(ai * 128 + m * 16) * EH) = w;
            }
    }
};
struct EpiY {
    static constexpr bool PERM = true;
    unsigned char* Y;
    __device__ __forceinline__ void operator()(AccT acc, const pg8::Unit& u, int wr, int wc, int fr, int fq) const {
        unsigned char* base = Y + (size_t)(u.pm * 256 + wr * 64 + fr) * D + u.pn * 256 + wc * 32 + 8 * fq;
#pragma unroll
        for (int ai = 0; ai < 2; ++ai)
#pragma unroll
            for (int m = 0; m < 4; ++m)
#pragma unroll
                for (int bj = 0; bj < 2; ++bj) { const f32x4 v0 = acc[ai][bj][m][0] * (Y8_SCALE / (W8_SCALE * H8_SCALE)), v1 = acc[ai][bj][m][1] * (Y8_SCALE / (W8_SCALE * H8_SCALE));
                    *(u32x2*)(base + (size_t)(ai * 128 + m * 16) * D + bj * 128) = (u32x2){pk4_fp8(sat8(v0[0]), sat8(v0[1]), sat8(v0[2]), sat8(v0[3])), pk4_fp8(sat8(v1[0]), sat8(v1[1]), sat8(v1[2]), sat8(v1[3]))}; }
    }
};
__device__ __forceinline__ void ph10(Frame& F) {
    build_tiles(F);
    const volatile LAS int* misc = (const volatile LAS int*)(F.lds + LDS_MISC);
    pg8::GroupOrder S{misc + MISC_TB, misc + MISC_CNT, (const volatile LAS int*)(F.lds + LDS_TL), (const volatile LAS int*)(F.lds + LDS_TL) + 320, misc + MISC_NFH, F.G, F.wg};
    SrcGU X{(const unsigned char*)(F.ws + WS_U), (const unsigned char*)(F.ws + WS_WGU), (const int*)(F.ws + WS_LIST), misc + MISC_CNT, D, D, D};
    EpiHid E{(unsigned char*)(F.ws + WS_H)};
    pg8::gemm_phase(F.lds, S, X, E);
}
__device__ __forceinline__ void ph11(Frame& F) {
    build_tiles(F);
    const volatile LAS int* misc = (const volatile LAS int*)(F.lds + LDS_MISC);
    pg8::GroupOrder S{misc + MISC_TB, misc + MISC_CNT, (const volatile LAS int*)(F.lds + LDS_TL), (const volatile LAS int*)(F.lds + LDS_TL) + 320, misc + MISC_NFH, F.G, F.wg};
    SrcDown X{(const unsigned char*)(F.ws + WS_H), (const unsigned char*)(F.ws + WS_WD), EH, EH, EH};
    EpiY E{F.ws + WS_Y};
    pg8::gemm_phase(F.lds, S, X, E);
}

struct FinRow { f32x4 v[8]; unsigned y0[8], y1[8]; };
__device__ __forceinline__ void ph_final(Frame& F, int mode) {
    const Args& a = *F.a;
    build_tiles(F);
    const volatile LAS int* tb = (const volatile LAS int*)(F.lds + LDS_MISC) + MISC_TB;
    const int row0 = (F.wg * NWAVES + F.wave) * 16;
    const float* g2 = (const float*)(F.ws + WS_MODF) + (size_t)(F.wg / 64) * 6 * D + 5 * D;
    const unsigned char* Y = F.ws + WS_Y;
    f32x4 gg[8], nf[8];
#pragma unroll
    for (int j = 0; j < 8; ++j) { gg[j] = *(const f32x4*)(g2 + 4 * F.lane + 256 * j); nf[j] = *(const f32x4*)(a.in[I_NFIN] + 4 * F.lane + 256 * j); }
    const int l16 = F.lane & 15;
    const int4 as = ((const int4*)(F.ws + WS_ASG))[row0 + l16]; const float* wvp = (const float*)(F.ws + WS_ASGW) + 2 * (size_t)(row0 + l16); const int wvx = __builtin_bit_cast(int, wvp[0]), wvy = __builtin_bit_cast(int, wvp[1]);
    const unsigned s0v = (unsigned)(tb[as.x] * 256 + as.y), s1v = (unsigned)(tb[as.z] * 256 + as.w);
#define FIN_LOAD(R, r_) do { const unsigned s0 = (unsigned)__builtin_amdgcn_readlane((int)s0v, (r_)), s1 = (unsigned)__builtin_amdgcn_readlane((int)s1v, (r_)); \
        const bf16* src = (const bf16*)(F.ws + WS_H1) + (size_t)(row0 + (r_)) * D + 4 * F.lane; const unsigned char* y0p = Y + (size_t)s0 * D + 4 * F.lane; const unsigned char* y1p = Y + (size_t)s1 * D + 4 * F.lane; \
        _Pragma("unroll") for (int j = 0; j < 8; ++j) { { const u32x2 hb = __builtin_nontemporal_load((const u32x2*)(src + 256 * j)); R.v[j].x = __uint_as_float(hb.x); R.v[j].y = __uint_as_float(hb.y); } R.y0[j] = __builtin_nontemporal_load((const unsigned*)(y0p + 256 * j)); R.y1[j] = __builtin_nontemporal_load((const unsigned*)(y1p + 256 * j)); } } while (0)
#define FIN_DO(R, r_) do { const float w0 = __builtin_bit_cast(float, __builtin_amdgcn_readlane(wvx, (r_))) * (1.0f / Y8_SCALE), w1 = __builtin_bit_cast(float, __builtin_amdgcn_readlane(wvy, (r_))) * (1.0f / Y8_SCALE); \
        float s = 0.f; \
        _Pragma("unroll") for (int j = 0; j < 8; ++j) { \
            const f32x2 a0 = __builtin_amdgcn_cvt_pk_f32_fp8((int)R.y0[j], false), a1 = __builtin_amdgcn_cvt_pk_f32_fp8((int)R.y0[j], true), b0 = __builtin_amdgcn_cvt_pk_f32_fp8((int)R.y1[j], false), b1 = __builtin_amdgcn_cvt_pk_f32_fp8((int)R.y1[j], true); \
            f32x4 y; y.x = w0 * a0.x + w1 * b0.x; y.y = w0 * a0.y + w1 * b0.y; y.z = w0 * a1.x + w1 * b1.x; y.w = w0 * a1.y + w1 * b1.y; \
            { const unsigned hx = __float_as_uint(R.v[j].x), hy = __float_as_uint(R.v[j].y); R.v[j] = (f32x4){bf_lo(hx), bf_hi(hx), bf_lo(hy), bf_hi(hy)} + gg[j] * y; } s += (R.v[j].x * R.v[j].x + R.v[j].y * R.v[j].y) + (R.v[j].z * R.v[j].z + R.v[j].w * R.v[j].w); } \
        const float rstd = rsqrtf(wave_sum(s) * (1.0f / D) + EPS); \
        float* dst = a.out + (size_t)(row0 + (r_)) * D + 4 * F.lane; \
        _Pragma("unroll") for (int j = 0; j < 8; ++j) __builtin_nontemporal_store(R.v[j] * rstd * nf[j], (f32x4*)(dst + 256 * j)); } while (0)
    FinRow A, B;
    FIN_LOAD(A, 0);
#pragma unroll 1
    for (int r = 0; r < 16; r += 2) {
        FIN_LOAD(B, r + 1);
        FIN_DO(A, r);
        if (r + 2 < 16) FIN_LOAD(A, r + 2);
        FIN_DO(B, r + 1);
    }
#undef FIN_LOAD
#undef FIN_DO
}

__global__ void __launch_bounds__(NTHR, 2) fwd(Args args) {
    extern __shared__ __attribute__((aligned(16))) unsigned char lds_raw[];
    Frame F;
    F.lds = (LAS unsigned char*)lds_raw;
    F.tid = threadIdx.x; F.lane = F.tid & 63; F.wave = __builtin_amdgcn_readfirstlane(F.tid >> 6);
    F.G = gridDim.x; F.wg = blockIdx.x; F.a = &args; F.ws = args.ws;
    volatile LAS unsigned* MISC = (volatile LAS unsigned*)(F.lds + LDS_MISC);
    if (F.tid < 256) MISC[F.tid] = 0u;
    __syncthreads();
    unsigned* ctl = (unsigned*)(args.ws + WS_CTL);
    const int lo = args.ph_lo, hi = args.ph_hi;
    XcdBarrier bar; bar.bar = ctl + CW_BAR; bar.x = 0; bar.st = MISC;
    if (hi - lo > 1) bar = xcd_barrier_post(ctl + CW_BAR, MISC);
#define IN(k) (lo <= (k) && (k) < hi)
#define SEAM(k) do { if (IN(k) && IN((k) + 1)) xcd_barrier(bar); } while (0)
    if (IN(0)) { ph0(F); } SEAM(0);
    if (IN(1)) { ph1(F); } SEAM(1);
    if (IN(2)) { ph2(F); } SEAM(2);
    if (IN(3)) { ph3(F, args.mode); } SEAM(3);
    if (IN(4)) { ph4(F); } SEAM(4);
    if (IN(5)) { ph5(F); } SEAM(5);
    if (IN(6)) { ph6(F); } if (IN(6) && IN(8)) xcd_barrier(bar);
    if (IN(8)) { ph8(F); } SEAM(8);
    if (IN(9)) { ph9(F); } SEAM(9);
    if (IN(10)) { ph10(F); } SEAM(10);
    if (IN(11)) { ph11(F); } SEAM(11);
    if (IN(12)) { ph_final(F, args.mode); }
#undef IN
#undef SEAM
}

extern "C" void kernel_launch(void* const* d_in, const int* in_sizes, int n_in, void* d_out, int out_size, void* d_ws, size_t ws_size, hipStream_t stream) {
    static int grid = 0;
    if (grid == 0) {
        if (n_in != 23 || out_size != T * D || ws_size < WS_END) { fprintf(stderr, "kernel_launch: unexpected sizes (n_in %d out %d ws %zu)\n", n_in, out_size, ws_size); grid = -1; return; }
        int dev = 0, cus = 0, per_cu = 0;
        if (hipGetDevice(&dev) != hipSuccess || hipDeviceGetAttribute(&cus, hipDeviceAttributeMultiprocessorCount, dev) != hipSuccess) { grid = -1; return; }
        if (hipFuncSetAttribute((const void*)fwd, hipFuncAttributeMaxDynamicSharedMemorySize, LDS_BYTES) != hipSuccess) { fprintf(stderr, "kernel_launch: hipFuncSetAttribute failed\n"); grid = -1; return; }
        if (hipOccupancyMaxActiveBlocksPerMultiprocessor(&per_cu, (const void*)fwd, NTHR, LDS_BYTES) != hipSuccess || per_cu < 1) fprintf(stderr, "kernel_launch: occupancy query says %d\n", per_cu);
        (void)hipGetLastError();
        grid = cus;
        if (grid != 256) { fprintf(stderr, "kernel_launch: built for 256 CUs, got %d\n", grid); grid = -1; return; }
    }
    if (grid < 0) return;
    (void)hipMemsetAsync((char*)d_ws + WS_CTL, 0, CTL_ZERO_BYTES, stream);
    Args a{};
    for (int i = 0; i < 23; ++i) a.in[i] = (const float*)d_in[i];
    a.out = (float*)d_out; a.ws = (unsigned char*)d_ws;
    a.ph_lo = 0; a.ph_hi = NPH; a.mode = 0; a.pad = 0;
    hipLaunchKernelGGL(fwd, dim3(grid), dim3(NTHR), LDS_BYTES, stream, a);
}
```

```cpp
#include <hip/hip_runtime.h>
#include <cstdio>
#include <cstdint>

#define GAS __attribute__((address_space(1)))
#define LAS __attribute__((address_space(3)))
typedef unsigned short bf16;
typedef short bf16x8 __attribute__((ext_vector_type(8)));
typedef float f32x4 __attribute__((ext_vector_type(4)));
typedef float f32x2 __attribute__((ext_vector_type(2)));
typedef unsigned u32x4 __attribute__((ext_vector_type(4)));
typedef unsigned u32x2 __attribute__((ext_vector_type(2)));
typedef int i32x4 __attribute__((ext_vector_type(4)));
typedef int i32x8 __attribute__((ext_vector_type(8)));

constexpr int D = 2048, NB = 4, SEQ = 8192, T = NB * SEQ;
constexpr int NZ = 11264, NZP = 11520, IN_DIM = 11280;
constexpr int NEXP = 64, EH = 1024;
constexpr int MAXSLOT = 81920;
constexpr float EPS = 1e-6f;
constexpr int NWAVES = 8, NTHR = 512;
constexpr int KSPLIT = 10, KSPL = 205;

constexpr size_t MiB = 1u << 20;
constexpr size_t WS_CTL = 0, CTL_ZERO_BYTES = 128 * 1024;
constexpr size_t WS_MODP = 1 * MiB;
constexpr size_t WS_MODF = 3 * MiB;
constexpr size_t WS_WRT = 4 * MiB;
constexpr size_t WS_WIN = 5 * MiB;
constexpr size_t WS_WA = 50 * MiB;
constexpr size_t WS_WPB = 58 * MiB;
constexpr size_t WS_WOUT = 62 * MiB;
constexpr size_t WS_WGU = 70 * MiB;
constexpr size_t WS_U8 = 326 * MiB;
constexpr size_t WS_WIN8 = 400 * MiB;
constexpr size_t WS_WD = 582 * MiB;
constexpr size_t WS_LIST = 838 * MiB;
constexpr size_t WS_ASG = 846 * MiB;
constexpr size_t WS_ASGW = WS_ASG + (size_t)T * 16;
constexpr size_t WS_U = 848 * MiB;
constexpr size_t WS_Z = 976 * MiB;
constexpr size_t WS_Q = WS_Z, WS_K = WS_Z + 64 * MiB, WS_V = WS_Z + 128 * MiB, WS_G = WS_Z + 256 * MiB, WS_P = WS_Z + 384 * MiB,
                 WS_GA = WS_Z + 448 * MiB, WS_GB = WS_Z + 576 * MiB, WS_GKLR = WS_Z + 704 * MiB;
constexpr size_t WS_GLA = 1682 * MiB;
constexpr size_t WS_KDT = WS_GLA, WS_ATT = WS_GLA + 64 * MiB, WS_DEC = WS_GLA + 80 * MiB, WS_O = WS_GLA + 82 * MiB, WS_M = WS_GLA + 210 * MiB;
constexpr size_t WS_RSS = 1956 * MiB;
constexpr size_t WS_END = 1960 * MiB;
constexpr size_t WS_H1 = WS_O;
constexpr size_t WS_Y = WS_Z;
constexpr size_t WS_H = WS_Z + 320 * MiB;
static_assert(WS_H + (size_t)MAXSLOT * EH * 2 <= WS_GKLR, "H/Y overlay");
constexpr int CW_TMO = 0, CW_BAR = 4096, CW_CNT = 8192;

constexpr int RING_BYTES = 131072;
constexpr int LDS_MISC = RING_BYTES;
constexpr int LDS_BYTES = 150 * 1024;

#define RLX_AGENT __ATOMIC_RELAXED, __HIP_MEMORY_SCOPE_AGENT
#define LDS_WAIT() asm volatile("s_waitcnt lgkmcnt(0)" ::: "memory")
#define VM_WAIT() asm volatile("s_waitcnt vmcnt(0)" ::: "memory")
typedef __bf16 bf16x2_t __attribute__((ext_vector_type(2)));
__device__ __forceinline__ unsigned cvt_pk_bf16(float lo, float hi) { const f32x2 v = {lo, hi}; return __builtin_bit_cast(unsigned, __builtin_convertvector(v, bf16x2_t)); }
__device__ __forceinline__ unsigned pk4_fp8(float a, float b, float c, float d) { int w = 0; w = __builtin_amdgcn_cvt_pk_fp8_f32(a, b, w, false); w = __builtin_amdgcn_cvt_pk_fp8_f32(c, d, w, true); return (unsigned)w; }
__device__ __forceinline__ float sat8(float v) { return __builtin_amdgcn_fmed3f(v, 448.0f, -448.0f); }
constexpr float W8_SCALE = 64.0f, H8_SCALE = 16.0f, Y8_SCALE = 16.0f;
__device__ __forceinline__ float bf_lo(unsigned w) { return __uint_as_float(w << 16); }
__device__ __forceinline__ float bf_hi(unsigned w) { return __uint_as_float(w & 0xffff0000u); }
__device__ __forceinline__ float dpp_add_(float v, const int ctrl_sel) {
    int r;
    if (ctrl_sel == 0) r = __builtin_amdgcn_update_dpp(0, __builtin_bit_cast(int, v), 0xB1, 0xf, 0xf, false);
    else if (ctrl_sel == 1) r = __builtin_amdgcn_update_dpp(0, __builtin_bit_cast(int, v), 0x4E, 0xf, 0xf, false);
    else if (ctrl_sel == 2) r = __builtin_amdgcn_update_dpp(0, __builtin_bit_cast(int, v), 0x141, 0xf, 0xf, false);
    else r = __builtin_amdgcn_update_dpp(0, __builtin_bit_cast(int, v), 0x140, 0xf, 0xf, false);
    return v + __builtin_bit_cast(float, r);
}
__device__ __forceinline__ float wave_sum(float v) {
    v = dpp_add_(v, 0); v = dpp_add_(v, 1); v = dpp_add_(v, 2); v = dpp_add_(v, 3);
    const float a = __builtin_bit_cast(float, __builtin_amdgcn_readlane(__builtin_bit_cast(int, v), 0)), b = __builtin_bit_cast(float, __builtin_amdgcn_readlane(__builtin_bit_cast(int, v), 16));
    const float c = __builtin_bit_cast(float, __builtin_amdgcn_readlane(__builtin_bit_cast(int, v), 32)), d = __builtin_bit_cast(float, __builtin_amdgcn_readlane(__builtin_bit_cast(int, v), 48));
    return (a + b) + (c + d);
}
__device__ __forceinline__ float sigmoidf_(float x) { return __builtin_amdgcn_rcpf(1.0f + __expf(-x)); }
__device__ __forceinline__ float siluf_(float x) { return x * __builtin_amdgcn_rcpf(1.0f + __expf(-x)); }

#define XB_TMO      128
#define XB_XCNT(j)  (256  + 64 * (j))
#define XB_XSUB(j)  (1280 + 64 * (j))
#define XB_XGEN(j)  (2304 + 64 * (j))
#define XB_TOP      3328
#define XB_TOPGEN   3392
#define XCD_BAR_WORDS 3456
#define XB_SPIN_CAP (1u << 18)
__device__ __forceinline__ unsigned xb_ld(unsigned* p)              { return __hip_atomic_load(p, __ATOMIC_RELAXED, __HIP_MEMORY_SCOPE_AGENT); }
__device__ __forceinline__ unsigned xb_add(unsigned* p, unsigned v) { return __hip_atomic_fetch_add(p, v, __ATOMIC_RELAXED, __HIP_MEMORY_SCOPE_AGENT); }
__device__ __forceinline__ unsigned xb_xcc_id() { return (unsigned)__builtin_amdgcn_s_getreg((3 << 11) | 20) & 0xFu; }
#define XB_SPIN(cond, bar) do { unsigned _sp = 0; while (cond) { __builtin_amdgcn_s_sleep(1); \
    if ((++_sp & 255u) == 0u) { if (xb_ld(&(bar)[XB_TMO])) break; if (_sp > XB_SPIN_CAP) { atomicAdd(&(bar)[XB_TMO], 1u); break; } } } } while (0)
struct XcdBarrier { unsigned* bar; unsigned x; volatile LAS unsigned* st; };
__device__ __forceinline__ XcdBarrier xcd_barrier_post(unsigned* bar, volatile LAS unsigned* st) {
    XcdBarrier b; b.bar = bar; b.x = xb_xcc_id(); b.st = st;
    if (threadIdx.x == 0) (void)xb_add(&bar[XB_XCNT(b.x)], 1u);
    return b;
}
__device__ __forceinline__ void xcd_barrier_complete(unsigned* bar, unsigned x, unsigned& nloc, unsigned& nx) {
    const unsigned G = gridDim.x * gridDim.y * gridDim.z;
    unsigned sum, cnt, mine, sp = 0u;
    for (;;) {
        sum = 0u; cnt = 0u; mine = 0u;
#pragma unroll
        for (unsigned j = 0; j < 16; ++j) { const unsigned c = xb_ld(&bar[XB_XCNT(j)]); sum += c; cnt += (c > 0u) ? 1u : 0u; mine = (j == x) ? c : mine; }
        if (sum == G) break;
        __builtin_amdgcn_s_sleep(1);
        if ((++sp & 255u) == 0u) { if (xb_ld(&bar[XB_TMO])) break; if (sp > XB_SPIN_CAP) { atomicAdd(&bar[XB_TMO], 1u); break; } }
    }
    nloc = mine > 0u ? mine : 1u; nx = cnt > 0u ? cnt : 1u;
}
__device__ __forceinline__ void xcd_barrier(const XcdBarrier& b) {
    asm volatile("s_waitcnt vmcnt(0)" ::: "memory");
    __syncthreads();
    if (threadIdx.x == 0) {
        unsigned* bar = b.bar;
        __builtin_amdgcn_s_waitcnt(0);
        unsigned nloc = b.st[0], nx = b.st[1];
        if (nloc == 0u) { xcd_barrier_complete(bar, b.x, nloc, nx); b.st[0] = nloc; b.st[1] = nx; }
        const unsigned old = xb_add(&bar[XB_XSUB(b.x)], 1u);
        const unsigned gen = old / nloc;
        if (old + 1u == (gen + 1u) * nloc) {
            __builtin_amdgcn_fence(__ATOMIC_RELEASE, "agent");
            asm volatile("s_waitcnt vmcnt(0)" ::: "memory");
            const unsigned og = xb_add(&bar[XB_TOP], 1u);
            const unsigned tg = og / nx;
            if (og + 1u == (tg + 1u) * nx) xb_add(&bar[XB_TOPGEN], 1u);
            else XB_SPIN(xb_ld(&bar[XB_TOPGEN]) == tg, bar);
            __builtin_amdgcn_fence(__ATOMIC_ACQUIRE, "agent");
            xb_add(&bar[XB_XGEN(b.x)], 1u);
            asm volatile("s_waitcnt vmcnt(0)" ::: "memory");
        } else {
            XB_SPIN(xb_ld(&bar[XB_XGEN(b.x)]) == gen, bar);
            __builtin_amdgcn_fence(__ATOMIC_ACQUIRE, "agent");
            asm volatile("s_waitcnt vmcnt(0)" ::: "memory");
        }
    }
    __syncthreads();
}

struct Args {
    const float* in[23];
    float* out; unsigned char* ws;
    int ph_lo, ph_hi, mode, pad;
};
enum { I_X = 0, I_C, I_WADA, I_BADA, I_NMIX, I_WIN, I_WGK2, I_BGK2, I_GLAN, I_WA, I_WPOOL, I_PSCALE, I_WB, I_WOUT, I_NFFN, I_WRG, I_BRG, I_WRE, I_BRE, I_WGATE, I_WUP, I_WDOWN, I_NFIN };
constexpr int NPH = 13;

struct Frame {
    LAS unsigned char* lds;
    int tid, lane, wave, G, wg;
    const Args* a;
    unsigned char* ws;
};


namespace pg8 {
constexpr int BM = 256, BK = 64, HALF = 128, HTB = HALF * BK * 2, STAGE_BYTES = 8 * HTB, NXCD = 8, WGM = 8;
__host__ __device__ __forceinline__ int lds_byte(int r, int c) { const int st = (r >> 4) * 2 + (c >> 5), rr = r & 15, cc = c & 31, ob = rr * 64 + cc * 2; return st * 1024 + (ob ^ (((ob >> 9) & 1) << 5)); }
__host__ __device__ __forceinline__ void stage_rc(int b, int& R, int& C) { const int st = b / 1024, sb = b % 1024, swz = sb ^ (((sb >> 9) & 1) << 5); R = (st >> 1) * 16 + swz / 64; C = (st & 1) * 32 + (swz % 64) / 2; }
__host__ __device__ __forceinline__ int perm32(int rho) { const int n = rho >> 4, i = rho & 15; return 8 * (i >> 2) + 4 * n + (i & 3); }
struct Unit { int pm, pn, e, r0, nrows; };

struct StaticOrder {
    static constexpr bool HALF = false;
    int nM, nN, nwg, G, c, off, lim;
    __device__ void init(int M, int N, int G_, int c_) { nM = M / BM; nN = N / BM; nwg = nM * nN; G = G_; c = c_; off = 0; lim = nwg; }
    __device__ bool next(int i, Unit& u) const {
        const long L = (long)i * G + c + off; if (L >= lim) return false;
        int wgid = (int)L; { const int q = nwg / NXCD, r = nwg % NXCD, xcd = wgid % NXCD, off = wgid / NXCD; wgid = (xcd < r ? xcd * (q + 1) : r * (q + 1) + (xcd - r) * q) + off; }
        const int nig = WGM * nN, gid = wgid / nig, fm = gid * WGM, gsz = (nM - fm) < WGM ? (nM - fm) : WGM;
        u.pm = fm + ((wgid % nig) % gsz); u.pn = (wgid % nig) / gsz; u.e = 0; u.r0 = 0; u.nrows = 256; return true;
    }
};
struct GroupOrder {
    static constexpr bool HALF = true;
    const volatile LAS int* tb; const volatile LAS int* cnt; const volatile LAS int* fl; const volatile LAS int* hl; const volatile LAS int* nfh; int G, c;
    __device__ bool next(int i, Unit& u) const {
        const int s = 4 * (c & 7) + (c >> 6), pn = (c >> 3) & 7;
        const int Fn = __builtin_amdgcn_readfirstlane(nfh[0]), Hn = __builtin_amdgcn_readfirstlane(nfh[1]);
        const int q = Fn >> 5, r = Fn & 31, nfull = q + (s < r ? 1 : 0);
        int mt;
        if (i < nfull) mt = __builtin_amdgcn_readfirstlane(fl[s + 32 * i]);
        else {
            const int k = i - nfull, cap = 2 * (32 - r), H1 = Hn < cap ? Hn : cap;
            int n1 = 0; if (s >= r) n1 = ((s - r) < H1 ? 1 : 0) + ((s - r) + (32 - r) < H1 ? 1 : 0);
            int hidx;
            if (k < n1) hidx = (s - r) + (32 - r) * k; else hidx = cap + s + 32 * (k - n1);
            if (hidx >= Hn) return false;
            mt = __builtin_amdgcn_readfirstlane(hl[hidx]);
        }
        int e = 0;
#pragma unroll
        for (int st = 32; st >= 1; st >>= 1) { const int t = __builtin_amdgcn_readfirstlane(tb[e + st]); if (t <= mt) e += st; }
        u.pm = mt; u.pn = pn; u.e = e; u.r0 = (mt - __builtin_amdgcn_readfirstlane(tb[e])) * 256; u.nrows = __builtin_amdgcn_readfirstlane(cnt[e]) - u.r0; return true;
    }
};

template <class Epi, class Sched, class Src>
__device__ __forceinline__ void gemm_phase(LAS unsigned char* lds, const Sched& S, const Src& X, const Epi& E) {
    const int tid = threadIdx.x, wid = __builtin_amdgcn_readfirstlane(tid >> 6), lane = tid & 63, wr = wid >> 2, wc = wid & 3, fr = lane & 15, fq = lane >> 4;
    constexpr int ES = Src::FP8 ? 1 : 2;
    const int K = X.K, nt = K / (Src::FP8 ? 2 * BK : BK);
    int Rr[2], Cc[2];
    unsigned voffB[2];
#pragma unroll
    for (int i = 0; i < 2; ++i) { stage_rc(tid * 16 + i * 8192, Rr[i], Cc[i]); const int Rb = Epi::PERM ? ((Rr[i] & ~31) + perm32(Rr[i] & 31)) : Rr[i]; voffB[i] = Src::BTILED ? (unsigned)(Rb * BK + Cc[i]) * 2u : (unsigned)(Rb * X.ldb) * ES + 2u * Cc[i]; }
    const size_t kstep = (size_t)(BK * 2);
    const size_t kstepB = Src::BTILED ? (size_t)(BM * BK * 2) : kstep;
    const size_t hstepB = Src::BTILED ? (size_t)(HALF * BK * 2) : (size_t)HALF * X.ldb * ES;
    const unsigned ldsw = (unsigned)wid * 1024u;
    const int aoff = lds_byte(wr * 64 + fr, fq * 8), boff = lds_byte(wc * 32 + fr, fq * 8);

#define PG8_SA(b, h) (((b) * 2 + (h)) * HTB)
#define PG8_SB(b, h) ((4 + (b) * 2 + (h)) * HTB)
#define PG8_STAGE(bufoff, gbase, voff) do { const char* _g = (const char*)(gbase); asm volatile("" : "+s"(_g)); _Pragma("unroll") for (int _i = 0; _i < 2; ++_i) \
        __builtin_amdgcn_global_load_lds((const unsigned*)(_g + (voff)[_i]), (LAS unsigned*)(lds + (bufoff) + ldsw + _i * 8192), 16, 0, 0); } while (0)
#define PG8_LDA(dst, b, h) do { if constexpr (Src::FP8) { _Pragma("unroll") for (int m = 0; m < 4; ++m) { dst##8[m].lo = *(const LAS i32x4*)(lds + PG8_SA(b, h) + aoff + m * 2048); dst##8[m].hi = *(const LAS i32x4*)(lds + PG8_SA(b, h) + aoff + m * 2048 + 1024); } } \
        else { _Pragma("unroll") for (int m = 0; m < 4; ++m) _Pragma("unroll") for (int k = 0; k < 2; ++k) dst[m][k] = *(const LAS bf16x8*)(lds + PG8_SA(b, h) + aoff + m * 2048 + k * 1024); } } while (0)
#define PG8_LDB(dst, b, h) do { if constexpr (Src::FP8) { _Pragma("unroll") for (int n = 0; n < 2; ++n) { dst##8[n].lo = *(const LAS i32x4*)(lds + PG8_SB(b, h) + boff + n * 2048); dst##8[n].hi = *(const LAS i32x4*)(lds + PG8_SB(b, h) + boff + n * 2048 + 1024); } } \
        else { _Pragma("unroll") for (int n = 0; n < 2; ++n) _Pragma("unroll") for (int k = 0; k < 2; ++k) dst[n][k] = *(const LAS bf16x8*)(lds + PG8_SB(b, h) + boff + n * 2048 + k * 1024); } } while (0)
#define PG8_MMA(ai, bj, At, Bt) do { if constexpr (!Src::FP8) __builtin_amdgcn_s_setprio(1); _Pragma("unroll") for (int m = 0; m < 4; ++m) _Pragma("unroll") for (int n = 0; n < 2; ++n) { \
        if constexpr (Src::FP8) acc[ai][bj][m][n] = __builtin_amdgcn_mfma_scale_f32_16x16x128_f8f6f4(Bt##8[n], At##8[m], acc[ai][bj][m][n], 0, 0, 0, 0x7F7F7F7F, 0, 0x7F7F7F7F); \
        else { _Pragma("unroll") for (int k = 0; k < 2; ++k) acc[ai][bj][m][n] = __builtin_amdgcn_mfma_f32_16x16x32_bf16(Bt[n][k], At[m][k], acc[ai][bj][m][n], 0, 0, 0); } } \
        if constexpr (!Src::FP8) __builtin_amdgcn_s_setprio(0); } while (0)
#define PG8_WAIT_V(n) asm volatile("s_waitcnt vmcnt(" #n ")" ::: "memory")
#define PG8_WAIT_L(n) asm volatile("s_waitcnt lgkmcnt(" #n ")" ::: "memory")
#define PG8_WAIT_VN(n) asm volatile("s_waitcnt vmcnt(%0)" :: "n"(n) : "memory")
#define PG8_BAR __builtin_amdgcn_s_barrier()
#define PG8_SCHED __builtin_amdgcn_sched_barrier(0)
    constexpr int W1 = 8, W2 = 6;
    Unit cur, nxt; int ui = 0;
    if (!S.next(0, cur)) return;
    f32x4 acc[2][2][4][2];
#pragma unroll
    for (int a = 0; a < 2; ++a)
#pragma unroll
        for (int b = 0; b < 2; ++b)
#pragma unroll
            for (int m = 0; m < 4; ++m)
#pragma unroll
                for (int n = 0; n < 2; ++n) acc[a][b][m][n] = (f32x4){0.f, 0.f, 0.f, 0.f};
    bf16x8 At[4][2], B0[2][2], B1[2][2];
    i32x8 At8[4], B08[2], B18[2];
    unsigned cv0[2], cv1[2], nv0[2], nv1[2];
#pragma unroll
    for (int i = 0; i < 2; ++i) {
        if constexpr (Src::GATHER) { cv0[i] = (unsigned)(X.rows(cur, Rr[i]) * X.lda) * ES + 2u * Cc[i]; cv1[i] = (unsigned)(X.rows(cur, Rr[i] + HALF) * X.lda) * ES + 2u * Cc[i]; }
        else { cv0[i] = (unsigned)(Rr[i] * X.lda) * ES + 2u * Cc[i]; cv1[i] = (unsigned)((Rr[i] + HALF) * X.lda) * ES + 2u * Cc[i]; }
        nv0[i] = cv0[i]; nv1[i] = cv1[i];
    }
    const char* cA = X.a_ptr(cur); const char* cB = X.b_ptr(cur);
    PG8_STAGE(PG8_SB(0, 0), cB, voffB); PG8_STAGE(PG8_SB(0, 1), cB + hstepB, voffB); PG8_STAGE(PG8_SA(0, 0), cA, cv0); PG8_STAGE(PG8_SA(0, 1), cA, cv1);
    if (wr == 1) PG8_BAR;
    PG8_WAIT_V(2); PG8_BAR;
    PG8_STAGE(PG8_SB(1, 0), cB + kstepB, voffB); PG8_STAGE(PG8_SA(1, 0), cA + kstep, cv0); PG8_STAGE(PG8_SB(1, 1), cB + hstepB + kstepB, voffB);
    PG8_WAIT_V(6); PG8_BAR;
    for (;;) {
        const bool has_next = S.next(ui + 1, nxt);
        const char* nA = has_next ? X.a_ptr(nxt) : cA; const char* nB = has_next ? X.b_ptr(nxt) : cB;
        if constexpr (Src::GATHER) {
            if (has_next) {
#pragma unroll
                for (int i = 0; i < 2; ++i) { nv0[i] = (unsigned)(X.rows(nxt, Rr[i]) * X.lda) * ES + 2u * Cc[i]; nv1[i] = (unsigned)(X.rows(nxt, Rr[i] + HALF) * X.lda) * ES + 2u * Cc[i]; }
            } else {
#pragma unroll
                for (int i = 0; i < 2; ++i) { nv0[i] = cv0[i]; nv1[i] = cv1[i]; }
            }
        }
        for (int t = 0; t < nt; t += 2) {
            const bool last = (t == nt - 2);
            const bool full = Src::FP8 || !Sched::HALF || cur.nrows > HALF;
            const char* a1 = cA + (size_t)(t + 1) * kstep;
            const char* a2 = last ? nA : cA + (size_t)(t + 2) * kstep; const char* b2 = last ? nB : cB + (size_t)(t + 2) * kstepB;
            const char* a3 = a2 + kstep; const char* b3 = b2 + kstepB;
            unsigned w0[2], w1[2];
#pragma unroll
            for (int i = 0; i < 2; ++i) { if constexpr (Src::GATHER) { w0[i] = last ? nv0[i] : cv0[i]; w1[i] = last ? nv1[i] : cv1[i]; } else { w0[i] = cv0[i]; w1[i] = cv1[i]; } }
            PG8_LDB(B0, 0, 0); PG8_LDB(B1, 0, 1); PG8_SCHED; PG8_LDA(At, 0, 0); PG8_STAGE(PG8_SA(1, 1), a1, cv1);
            PG8_WAIT_VN(W1); PG8_WAIT_L(0); PG8_BAR; PG8_MMA(0, 0, At, B0); PG8_MMA(0, 1, At, B1); PG8_BAR; PG8_SCHED;
            if (full) PG8_LDA(At, 0, 1); PG8_STAGE(PG8_SB(0, 0), b2, voffB); PG8_STAGE(PG8_SB(0, 1), b2 + hstepB, voffB);
            PG8_WAIT_VN(W2); PG8_WAIT_L(0); PG8_BAR; if (full) { PG8_MMA(1, 0, At, B0); PG8_MMA(1, 1, At, B1); } PG8_SCHED; PG8_STAGE(PG8_SA(0, 0), a2, w0); PG8_BAR; PG8_SCHED;
            PG8_LDB(B0, 1, 0); PG8_LDB(B1, 1, 1); PG8_SCHED; PG8_LDA(At, 1, 0); PG8_STAGE(PG8_SA(0, 1), a2, w1);
            PG8_WAIT_VN(W1); PG8_WAIT_L(0); PG8_BAR; PG8_MMA(0, 0, At, B0); PG8_MMA(0, 1, At, B1); PG8_BAR; PG8_SCHED;
            if (full) PG8_LDA(At, 1, 1); PG8_STAGE(PG8_SB(1, 0), b3, voffB); PG8_STAGE(PG8_SB(1, 1), b3 + hstepB, voffB);
            PG8_WAIT_VN(W2); PG8_WAIT_L(0); PG8_BAR; if (full) { PG8_MMA(1, 0, At, B0); PG8_MMA(1, 1, At, B1); } PG8_SCHED; PG8_STAGE(PG8_SA(1, 0), a3, w0); PG8_BAR; PG8_SCHED;
        }
        if (wr == 0) PG8_BAR;
        { int tz = threadIdx.x; asm volatile("" : "+v"(tz)); const int wz = __builtin_amdgcn_readfirstlane(tz >> 6), lz = tz & 63; E(acc, cur, wz >> 2, wz & 3, lz & 15, lz >> 4); }
        if (!has_next) break;
#pragma unroll
        for (int a = 0; a < 2; ++a)
#pragma unroll
            for (int b = 0; b < 2; ++b)
#pragma unroll
                for (int m = 0; m < 4; ++m)
#pragma unroll
                    for (int n = 0; n < 2; ++n) acc[a][b][m][n] = (f32x4){0.f, 0.f, 0.f, 0.f};
        cur = nxt; cA = nA; cB = nB; ++ui;
        if constexpr (Src::GATHER) {
#pragma unroll
            for (int i = 0; i < 2; ++i) { cv0[i] = nv0[i]; cv1[i] = nv1[i]; }
        }
        if (wr == 1) PG8_BAR;
    }
    PG8_WAIT_V(0);
    PG8_BAR;
#undef PG8_SA
#undef PG8_SB
#undef PG8_STAGE
#undef PG8_LDA
#undef PG8_LDB
#undef PG8_MMA
#undef PG8_WAIT_V
#undef PG8_WAIT_L
#undef PG8_WAIT_VN
#undef PG8_BAR
#undef PG8_SCHED
}
}


template <class RowMap>
__device__ __forceinline__ void cvt_tile(const float* __restrict__ W, int N, int K, bf16* __restrict__ dst, int k0, int n0, int lane, const RowMap& rm) {
    const int kb = lane & 7, nb = lane >> 3, n = n0 + 4 * nb;
    if (n >= N) return;
    f32x4 v[8];
    const float* p = W + (size_t)(k0 + 8 * kb) * N + n;
#pragma unroll
    for (int j = 0; j < 8; ++j) v[j] = *(const f32x4*)(p + (size_t)j * N);
#pragma unroll
    for (int i = 0; i < 4; ++i) {
        u32x4 o; o.x = cvt_pk_bf16(v[0][i], v[1][i]); o.y = cvt_pk_bf16(v[2][i], v[3][i]); o.z = cvt_pk_bf16(v[4][i], v[5][i]); o.w = cvt_pk_bf16(v[6][i], v[7][i]);
        *(u32x4*)(dst + (size_t)rm(n + i) * K + k0 + 8 * kb) = o;
    }
}
struct RowId { __device__ __forceinline__ int operator()(int n) const { return n; } };
struct RowWin { __device__ __forceinline__ int operator()(int n) const { return n < 6144 ? n : (n < 6160 ? NZ + (n - 6144) : n - 16); } };
struct ZMap { int split, off0, off1; __device__ __forceinline__ int operator()(int j) const { return j + (j < split ? off0 : off1); } };
__host__ __device__ constexpr bool z_is16(int pn) { return pn >= 24 && pn < 28; }
constexpr int NZ16 = 4;
constexpr ZMap ZMAP8{24, 0, 4}, ZMAP16{0, 0, 24};
__device__ __forceinline__ void cvt_tile_win(const float* __restrict__ W, unsigned char* __restrict__ dst8, bf16* __restrict__ dst16, int k0, int n0, int lane) {
    const int kb = lane & 7, nb = lane >> 3, n = n0 + 4 * nb;
    if (n >= IN_DIM) return;
    f32x4 v[8];
    const float* p = W + (size_t)(k0 + 8 * kb) * IN_DIM + n;
#pragma unroll
    for (int j = 0; j < 8; ++j) v[j] = *(const f32x4*)(p + (size_t)j * IN_DIM);
    const int r0 = RowWin{}(n);
    if (r0 >= NZ || z_is16(r0 >> 8)) {
#pragma unroll
        for (int i = 0; i < 4; ++i) {
            u32x4 o; o.x = cvt_pk_bf16(v[0][i], v[1][i]); o.y = cvt_pk_bf16(v[2][i], v[3][i]); o.z = cvt_pk_bf16(v[4][i], v[5][i]); o.w = cvt_pk_bf16(v[6][i], v[7][i]);
            *(u32x4*)(dst16 + (size_t)(r0 + i) * D + k0 + 8 * kb) = o;
        }
    } else {
#pragma unroll
        for (int i = 0; i < 4; ++i) {
            u32x2 o; o.x = pk4_fp8(v[0][i] * W8_SCALE, v[1][i] * W8_SCALE, v[2][i] * W8_SCALE, v[3][i] * W8_SCALE); o.y = pk4_fp8(v[4][i] * W8_SCALE, v[5][i] * W8_SCALE, v[6][i] * W8_SCALE, v[7][i] * W8_SCALE);
            *(u32x2*)(dst8 + (size_t)(r0 + i) * D + k0 + 8 * kb) = o;
        }
    }
}
__device__ __forceinline__ void cvt_tile8(const float* __restrict__ W, int N, int K, unsigned char* __restrict__ dst8, int k0, int n0, int lane) {
    const int kb = lane & 7, nb = lane >> 3, n = n0 + 4 * nb;
    f32x4 v[8];
    const float* p = W + (size_t)(k0 + 8 * kb) * N + n;
#pragma unroll
    for (int j = 0; j < 8; ++j) v[j] = *(const f32x4*)(p + (size_t)j * N);
#pragma unroll
    for (int i = 0; i < 4; ++i) {
        u32x2 o; o.x = pk4_fp8(v[0][i] * W8_SCALE, v[1][i] * W8_SCALE, v[2][i] * W8_SCALE, v[3][i] * W8_SCALE); o.y = pk4_fp8(v[4][i] * W8_SCALE, v[5][i] * W8_SCALE, v[6][i] * W8_SCALE, v[7][i] * W8_SCALE);
        *(u32x2*)(dst8 + (size_t)(n + i) * K + k0 + 8 * kb) = o;
    }
}
struct RowGU { int sel; __device__ __forceinline__ int operator()(int h) const { const int pn = h >> 7, r = h & 127, wc = r >> 5, r5 = r & 31, fq = r5 >> 3, bj = (r5 >> 2) & 1, j = r5 & 3; return 256 * pn + 128 * bj + 32 * wc + 16 * sel + 4 * fq + j; } };

__device__ __forceinline__ void ph0(Frame& F) {
    const Args& a = *F.a;
    unsigned char* ws = F.ws;
    if (F.wg < 24 * KSPLIT) {
        const int jc = F.wg % 24, ks = F.wg / 24, j = jc * 512 + F.tid;
        const int kbeg = ks * KSPL, kend = (kbeg + KSPL < D) ? kbeg + KSPL : D;
        LAS float* sc = (LAS float*)F.lds;
        for (int i = F.tid; i < 4 * KSPL; i += NTHR) { const int b = i / KSPL, kk = i % KSPL; sc[i] = (kbeg + kk < D) ? siluf_(a.in[I_C][b * D + kbeg + kk]) : 0.f; }
        __syncthreads();
        float a0 = 0.f, a1 = 0.f, a2 = 0.f, a3 = 0.f;
        const float* w = a.in[I_WADA] + (size_t)kbeg * (6 * D) + j;
#pragma unroll 16
        for (int kk = 0; kk < kend - kbeg; ++kk) { const float wv = w[(size_t)kk * (6 * D)]; a0 += sc[kk] * wv; a1 += sc[KSPL + kk] * wv; a2 += sc[2 * KSPL + kk] * wv; a3 += sc[3 * KSPL + kk] * wv; }
        float* mp = (float*)(ws + WS_MODP) + (size_t)ks * 4 * (6 * D) + j;
        mp[0] = a0; mp[6 * D] = a1; mp[2 * 6 * D] = a2; mp[3 * 6 * D] = a3;
        __syncthreads();
    }
    const int gw = F.wg * NWAVES + F.wave, NGW = F.G * NWAVES;
    {
        constexpr int I_IN = 32 * 353, I_SQ = 32 * 64;
        constexpr int NITEMS = I_IN + 2 * I_SQ;
        for (int it = gw; it < NITEMS; it += NGW) {
            int r = it;
            if (r < I_IN) { cvt_tile_win(a.in[I_WIN], ws + WS_WIN8, (bf16*)(ws + WS_WIN), 64 * (r / 353), 32 * (r % 353), F.lane); continue; } r -= I_IN;
            if (r < I_SQ) { cvt_tile8(a.in[I_WA], D, D, ws + WS_WA, 64 * (r / 64), 32 * (r % 64), F.lane); continue; } r -= I_SQ;
            cvt_tile(a.in[I_WOUT], D, D, (bf16*)(ws + WS_WOUT), 64 * (r / 64), 32 * (r % 64), F.lane, RowId{});
        }
    }
    const int gt = F.wg * NTHR + F.tid, NGT = F.G * NTHR;
    for (int i = gt; i < 80 * D; i += NGT) {
        const int n = i / D, k = i % D;
        const float v = n < 8 ? a.in[I_WRG][k * 8 + n] : (n < 72 ? a.in[I_WRE][k * 64 + (n - 8)] : 0.f);
        const unsigned h = cvt_pk_bf16(v, 0.f) & 0xffffu; const float hf = __uint_as_float(h << 16);
        const unsigned l = cvt_pk_bf16(v - hf, 0.f) & 0xffffu;
        ((bf16*)(ws + WS_WRT))[i] = (bf16)h; ((bf16*)(ws + WS_WRT))[80 * D + i] = (bf16)l;
    }
    __syncthreads();
    for (int u = F.wg; u < 128; u += F.G) {
        const int g = u >> 5, n0 = (u & 31) * 64, fr = F.lane & 15, fq = F.lane >> 4;
        constexpr int WP = 528;
#pragma unroll
        for (int i = 0; i < 8; ++i) { const int d = (F.tid >> 4) + 32 * i, nn = (F.tid & 15) * 4;
            const f32x4 v = *(const f32x4*)(a.in[I_WB] + (size_t)(g * 256 + d) * D + n0 + nn);
#pragma unroll
            for (int q = 0; q < 4; ++q) *(LAS bf16*)(F.lds + (nn + q) * WP + d * 2) = (bf16)(cvt_pk_bf16(v[q], 0.f) & 0xffffu); }
        __syncthreads();
        f32x4 acc[2][4];
#pragma unroll
        for (int cb = 0; cb < 2; ++cb)
#pragma unroll
            for (int nb = 0; nb < 4; ++nb) acc[cb][nb] = (f32x4){0.f, 0.f, 0.f, 0.f};
#pragma unroll
        for (int kk = 0; kk < 8; ++kk) {
            const f32x4 p0 = *(const f32x4*)(a.in[I_PSCALE] + g * 256 + 32 * kk + 8 * fq), p1 = *(const f32x4*)(a.in[I_PSCALE] + g * 256 + 32 * kk + 8 * fq + 4);
            bf16x8 af[2];
#pragma unroll
            for (int cb = 0; cb < 2; ++cb) { const float* wp = a.in[I_WPOOL] + ((size_t)g * 256 + (2 * F.wave + cb) * 16 + fr) * 256 + 32 * kk + 8 * fq;
                const f32x4 w0 = *(const f32x4*)wp * p0, w1 = *(const f32x4*)(wp + 4) * p1;
                af[cb] = __builtin_bit_cast(bf16x8, (u32x4){cvt_pk_bf16(w0[0], w0[1]), cvt_pk_bf16(w0[2], w0[3]), cvt_pk_bf16(w1[0], w1[1]), cvt_pk_bf16(w1[2], w1[3])}); }
#pragma unroll
            for (int nb = 0; nb < 4; ++nb) { const bf16x8 bfv = *(const LAS bf16x8*)(F.lds + (nb * 16 + fr) * WP + (32 * kk + 8 * fq) * 2);
#pragma unroll
                for (int cb = 0; cb < 2; ++cb) acc[cb][nb] = __builtin_amdgcn_mfma_f32_16x16x32_bf16(af[cb], bfv, acc[cb][nb], 0, 0, 0); }
        }
#pragma unroll
        for (int cb = 0; cb < 2; ++cb)
#pragma unroll
            for (int nb = 0; nb < 4; ++nb) { u32x2 o; o.x = cvt_pk_bf16(acc[cb][nb][0], acc[cb][nb][1]); o.y = cvt_pk_bf16(acc[cb][nb][2], acc[cb][nb][3]);
                *(u32x2*)((bf16*)(ws + WS_WPB) + (size_t)(n0 + 16 * nb + fr) * 1024 + g * 256 + (2 * F.wave + cb) * 16 + 4 * fq) = o; }
        __syncthreads();
    }
}
constexpr int CW_CVT = 16384;
constexpr int CT_PITCH = 144, CT_TILE = 256 * CT_PITCH;
struct CvtItem { const float* pa; unsigned char* dst; int N, K, k0, n0, sel; };
__device__ __forceinline__ bool cvt_decode(const Args& a, unsigned char* ws, unsigned it, int wave, int lane, CvtItem& c) {
    constexpr int PER_E = 3 * 64, NITEM = NEXP * PER_E;
    if (it >= (unsigned)NITEM) return false;
    const int e = (int)it / PER_E; int r = (int)it - e * PER_E;
    const float* W;
    if (r < 128) { c.sel = r >> 6; r &= 63; W = a.in[c.sel ? I_WUP : I_WGATE] + (size_t)e * D * EH; c.dst = ws + WS_WGU + (size_t)e * 2048 * D; c.N = EH; c.K = D; c.k0 = 128 * (r >> 2); c.n0 = 256 * (r & 3); }
    else { r -= 128; c.sel = -1; W = a.in[I_WDOWN] + (size_t)e * EH * D; c.dst = ws + WS_WD + (size_t)e * D * EH; c.N = D; c.K = EH; c.k0 = 128 * (r >> 3); c.n0 = 256 * (r & 7); }
    c.pa = W + (size_t)(c.k0 + 16 * wave) * c.N + c.n0 + 4 * lane;
    return true;
}
constexpr int CW_P2DONE = 16448;
__device__ __forceinline__ void cvt_experts(Frame& F, unsigned* stopctr = nullptr, unsigned stopval = 0u) {
    const Args& a = *F.a; unsigned char* ws = F.ws;
    unsigned* ctr = (unsigned*)(ws + WS_CTL) + CW_CVT;
#define CVT_TAKE() ((stopctr && __hip_atomic_load(stopctr, RLX_AGENT) >= stopval) ? 0xFFFFFFF0u : atomicAdd(ctr, 8u))
    volatile LAS unsigned* slot = (volatile LAS unsigned*)(F.lds + LDS_MISC) + 8;
    __syncthreads();
    f32x4 va[2][16]; CvtItem ci[2]; bool ok[2];
    unsigned base; int idx = 0, par = 0;
    if (F.tid == 0) slot[0] = CVT_TAKE();
    __syncthreads();
    base = slot[0];
    if (F.tid == 0) slot[1] = CVT_TAKE();
#define CVT_GRAB(s_) do { __syncthreads(); \
        if (idx == 8) { par ^= 1; base = slot[par]; idx = 0; if (F.tid == 0) slot[par ^ 1] = CVT_TAKE(); } \
        ok[s_] = cvt_decode(a, ws, base + (unsigned)idx, F.wave, F.lane, ci[s_]); ++idx; \
        if (ok[s_]) { _Pragma("unroll") for (int j = 0; j < 16; ++j) va[s_][j] = __builtin_nontemporal_load((const f32x4*)(ci[s_].pa + (size_t)j * ci[s_].N)); } } while (0)
#define CVT_PROC(s_) do { \
        _Pragma("unroll") for (int i = 0; i < 4; ++i) { \
            u32x4 o; o.x = pk4_fp8(va[s_][0][i] * W8_SCALE, va[s_][1][i] * W8_SCALE, va[s_][2][i] * W8_SCALE, va[s_][3][i] * W8_SCALE); \
            o.y = pk4_fp8(va[s_][4][i] * W8_SCALE, va[s_][5][i] * W8_SCALE, va[s_][6][i] * W8_SCALE, va[s_][7][i] * W8_SCALE); \
            o.z = pk4_fp8(va[s_][8][i] * W8_SCALE, va[s_][9][i] * W8_SCALE, va[s_][10][i] * W8_SCALE, va[s_][11][i] * W8_SCALE); \
            o.w = pk4_fp8(va[s_][12][i] * W8_SCALE, va[s_][13][i] * W8_SCALE, va[s_][14][i] * W8_SCALE, va[s_][15][i] * W8_SCALE); \
            *(LAS u32x4*)(F.lds + (4 * F.lane + i) * CT_PITCH + F.wave * 16) = o; } \
        __syncthreads(); \
        _Pragma("unroll") for (int i = 0; i < 4; ++i) { \
            const int row = 32 * F.wave + (F.lane >> 3) + 8 * i, pc = F.lane & 7; \
            const u32x4 o = *(const LAS u32x4*)(F.lds + row * CT_PITCH + pc * 16); \
            const int ra = ci[s_].sel >= 0 ? RowGU{ci[s_].sel}(ci[s_].n0 + row) : ci[s_].n0 + row; \
            __builtin_nontemporal_store(o, (u32x4*)(ci[s_].dst + (size_t)(ra >> 8) * 256 * ci[s_].K + (size_t)(((ci[s_].k0 >> 7) * 256 + (ra & 255)) * 128 + pc * 16))); } } while (0)
    CVT_GRAB(0);
    for (;;) {
        if (!ok[0]) break;
        CVT_GRAB(1);
        CVT_PROC(0);
        if (!ok[1]) break;
        CVT_GRAB(0);
        CVT_PROC(1);
    }
#undef CVT_GRAB
#undef CVT_PROC
#undef CVT_TAKE
}

__device__ __forceinline__ float mod_sum(const float* mp, const float* bada, int b, int j) {
    float s = bada[j];
#pragma unroll
    for (int ks = 0; ks < KSPLIT; ++ks) s += mp[((size_t)ks * 4 + b) * (6 * D) + j];
    return s;
}
__device__ __forceinline__ void ph1(Frame& F) {
    const Args& a = *F.a;
    const float* mp = (const float*)(F.ws + WS_MODP);
    if (F.wg < 24) { const int j = F.wg * 512 + F.tid; float* mf = (float*)(F.ws + WS_MODF);
#pragma unroll
        for (int b = 0; b < 4; ++b) mf[b * 6 * D + j] = mod_sum(mp, a.in[I_BADA], b, j); }
    const int b = F.wg / 64;
    LAS float* gm = (LAS float*)F.lds; LAS float* sh = gm + D;
    for (int c = F.tid; c < D; c += NTHR) { gm[c] = a.in[I_NMIX][c] * (1.0f + mod_sum(mp, a.in[I_BADA], b, D + c)); sh[c] = mod_sum(mp, a.in[I_BADA], b, c); }
    __syncthreads();
    f32x4 g4[8], s4[8];
#pragma unroll
    for (int j = 0; j < 8; ++j) { g4[j] = *(const LAS f32x4*)(gm + 4 * F.lane + 256 * j); s4[j] = *(const LAS f32x4*)(sh + 4 * F.lane + 256 * j); }
    bf16* U = (bf16*)(F.ws + WS_U); unsigned char* U8 = F.ws + WS_U8;
    for (int r = 0; r < 16; ++r) {
        const int row = F.wg * 128 + F.wave * 16 + r;
        const float* src = a.in[I_X] + (size_t)row * D;
        f32x4 v[8]; float s = 0.f;
#pragma unroll
        for (int j = 0; j < 8; ++j) { v[j] = __builtin_nontemporal_load((const f32x4*)(src + 4 * F.lane + 256 * j)); s += (v[j].x * v[j].x + v[j].y * v[j].y) + (v[j].z * v[j].z + v[j].w * v[j].w); }
        const float rstd = rsqrtf(wave_sum(s) * (1.0f / D) + EPS);
#pragma unroll
        for (int j = 0; j < 8; ++j) { const f32x4 y = v[j] * rstd * g4[j] + s4[j]; u32x2 o; o.x = cvt_pk_bf16(y.x, y.y); o.y = cvt_pk_bf16(y.z, y.w);
            *(u32x2*)(U + (size_t)row * D + 4 * F.lane + 256 * j) = o;
            *(unsigned*)(U8 + (size_t)row * D + 4 * F.lane + 256 * j) = pk4_fp8(y.x, y.y, y.z, y.w); }
    }
    __syncthreads();
}

struct SrcDense {
    static constexpr bool GATHER = false, BTILED = false, FP8 = false;
    const bf16* A; const bf16* Bt; int K, lda, ldb;
    __device__ __forceinline__ const char* a_ptr(const pg8::Unit& u) const { return (const char*)(A + (size_t)u.pm * 256 * lda); }
    __device__ __forceinline__ const char* b_ptr(const pg8::Unit& u) const { return (const char*)(Bt + (size_t)u.pn * 256 * ldb); }
    __device__ __forceinline__ int rows(const pg8::Unit&, int r) const { return r; }
};
template <bool F8>
struct SrcZ {
    static constexpr bool GATHER = false, BTILED = false, FP8 = F8;
    const unsigned char* A; const unsigned char* Bt; int K, lda, ldb; ZMap zm;
    __device__ __forceinline__ const char* a_ptr(const pg8::Unit& u) const { return (const char*)(A + (size_t)u.pm * 256 * lda * (F8 ? 1 : 2)); }
    __device__ __forceinline__ const char* b_ptr(const pg8::Unit& u) const { return (const char*)(Bt + (size_t)zm(u.pn) * 256 * ldb * (F8 ? 1 : 2)); }
    __device__ __forceinline__ int rows(const pg8::Unit&, int r) const { return r; }
};
typedef const f32x4 (&AccT)[2][2][4][2];
struct EpiZ {
    static constexpr bool PERM = true;
    unsigned char* ws; ZMap zm; float sc;
    __device__ __forceinline__ void operator()(AccT acc, const pg8::Unit& u, int wr, int wc, int fr, int fq) const {
        const int row0 = u.pm * 256 + wr * 64 + fr, pn = zm(u.pn);
        size_t off; int ld, ct;
        if (pn < 4) { off = WS_Q; ld = 1024; ct = pn; } else if (pn < 8) { off = WS_K; ld = 1024; ct = pn - 4; } else if (pn < 16) { off = WS_V; ld = 2048; ct = pn - 8; }
        else if (pn < 24) { off = WS_G; ld = 2048; ct = pn - 16; } else if (pn < 28) { off = WS_P; ld = 1024; ct = pn - 24; } else if (pn < 36) { off = WS_GA; ld = 2048; ct = pn - 28; }
        else { off = WS_GB; ld = 2048; ct = pn - 36; }
        bf16* base = (bf16*)(ws + off) + ct * 256 + wc * 32 + 8 * fq;
#pragma unroll
        for (int ai = 0; ai < 2; ++ai)
#pragma unroll
            for (int m = 0; m < 4; ++m) { bf16* rowp = base + (size_t)(row0 + ai * 128 + m * 16) * ld;
#pragma unroll
                for (int bj = 0; bj < 2; ++bj) { const f32x4 v0 = acc[ai][bj][m][0] * sc, v1 = acc[ai][bj][m][1] * sc;
                    u32x4 w; w.x = cvt_pk_bf16(v0[0], v0[1]); w.y = cvt_pk_bf16(v0[2], v0[3]); w.z = cvt_pk_bf16(v1[0], v1[1]); w.w = cvt_pk_bf16(v1[2], v1[3]);
                    *(u32x4*)(rowp + bj * 128) = w; } }
    }
};
__device__ __forceinline__ void ph2(Frame& F) {
    { pg8::StaticOrder S; S.init(T, NZ - 256 * NZ16, F.G, F.wg);
      SrcZ<true> X{F.ws + WS_U8, F.ws + WS_WIN8, D, D, D, ZMAP8};
      EpiZ E{F.ws, ZMAP8, 1.0f / W8_SCALE};
      pg8::gemm_phase(F.lds, S, X, E); }
    { pg8::StaticOrder S; S.init(T, 256 * NZ16, F.G, F.wg);
      SrcZ<false> X{F.ws + WS_U, F.ws + WS_WIN, D, D, D, ZMAP16};
      EpiZ E{F.ws, ZMAP16, 1.0f};
      pg8::gemm_phase(F.lds, S, X, E); }
}


constexpr int GP_LR = 0, GP_TOT = 4096, GP_QS = 8192, GP_KS = 8192 + 33792, GP_PITCH = 528;
typedef short s16x4 __attribute__((ext_vector_type(4)));
__device__ __forceinline__ float logsig_(float x) { return fminf(x, 0.f) - __logf(1.0f + __expf(-fabsf(x))); }
__device__ __forceinline__ void gla_prep_tile(Frame& F, int tile) {
    const Args& a = *F.a;
    const int b = tile >> 7, n = tile & 127, t0 = tile * 64;
    const int cp = F.tid & 127, rq = F.tid >> 7, d0 = 2 * cp, fr = F.lane & 15, fq = F.lane >> 4;
    LAS float* lr = (LAS float*)(F.lds + GP_LR); LAS float* tot = (LAS float*)(F.lds + GP_TOT);
    bf16* Q = (bf16*)(F.ws + WS_Q); const bf16* Kp = (const bf16*)(F.ws + WS_K);
    {
        const bf16* U = (const bf16*)(F.ws + WS_U) + (size_t)(t0 + fr) * D + 256 * F.wave + 8 * fq;
        const bf16* Wl = (const bf16*)(F.ws + WS_WIN) + (size_t)(NZ + fr) * D + 256 * F.wave + 8 * fq;
        f32x4 acc[4];
#pragma unroll
        for (int rb = 0; rb < 4; ++rb) acc[rb] = (f32x4){0.f, 0.f, 0.f, 0.f};
#pragma unroll
        for (int kk = 0; kk < 8; ++kk) {
            const bf16x8 bw = *(const bf16x8*)(Wl + 32 * kk);
#pragma unroll
            for (int rb = 0; rb < 4; ++rb) { const bf16x8 au = *(const bf16x8*)(U + (size_t)rb * 16 * D + 32 * kk); acc[rb] = __builtin_amdgcn_mfma_f32_16x16x32_bf16(au, bw, acc[rb], 0, 0, 0); }
        }
        LAS f32x4* part = (LAS f32x4*)(F.lds + GP_QS);
#pragma unroll
        for (int rb = 0; rb < 4; ++rb) part[(F.wave * 4 + rb) * 64 + F.lane] = acc[rb];
        __syncthreads();
#pragma unroll
        for (int s = 0; s < 2; ++s) { const int o = 2 * F.tid + s, tk = o >> 4, col = o & 15, rb = tk >> 4, l = ((tk & 15) >> 2) * 16 + col, r = tk & 3; float v = 0.f;
#pragma unroll
            for (int w = 0; w < 8; ++w) v += ((const LAS float*)(part + (w * 4 + rb) * 64 + l))[r];
            lr[o] = v; }
        __syncthreads();
    }
    unsigned qv[16], kv[16];
#pragma unroll
    for (int ii = 0; ii < 16; ++ii) { const size_t go = (size_t)(t0 + rq * 16 + ii) * 1024 + d0; qv[ii] = *(const unsigned*)(Q + go); kv[ii] = *(const unsigned*)(Kp + go); }
#pragma unroll 1
    for (int h = 0; h < 4; ++h) {
        const int ci = (b * 4 + h) * 128 + n;
        float w2a[16], w2b[16];
#pragma unroll
        for (int r = 0; r < 16; ++r) { const f32x2 w = *(const f32x2*)(a.in[I_WGK2] + r * 1024 + h * 256 + d0); w2a[r] = w.x; w2b[r] = w.y; }
        const f32x2 b2 = *(const f32x2*)(a.in[I_BGK2] + h * 256 + d0);
        float bc0[16], bc1[16]; float cum0 = 0.f, cum1 = 0.f;
#pragma unroll
        for (int ii = 0; ii < 16; ++ii) {
            const int i = rq * 16 + ii; float g0 = b2.x, g1 = b2.y;
#pragma unroll
            for (int r4 = 0; r4 < 4; ++r4) { const f32x4 l4 = *(const LAS f32x4*)(lr + i * 16 + 4 * r4);
#pragma unroll
                for (int r = 0; r < 4; ++r) { g0 += l4[r] * w2a[4 * r4 + r]; g1 += l4[r] * w2b[4 * r4 + r]; } }
            cum0 += logsig_(g0) * (1.0f / 16.0f); cum1 += logsig_(g1) * (1.0f / 16.0f);
            bc0[ii] = cum0; bc1[ii] = cum1;
        }
        *(LAS f32x2*)(tot + rq * 256 + d0) = (f32x2){cum0, cum1};
        __syncthreads();
        float pre0 = 0.f, pre1 = 0.f, bl0 = 0.f, bl1 = 0.f;
#pragma unroll
        for (int q = 0; q < 4; ++q) { const f32x2 tq = *(const LAS f32x2*)(tot + q * 256 + d0); bl0 += tq.x; bl1 += tq.y; if (q < rq) { pre0 += tq.x; pre1 += tq.y; } }
        unsigned kd0[8], kd1[8];
#pragma unroll
        for (int ii = 0; ii < 16; ii += 2) {
            float k0v[2], k1v[2];
#pragma unroll
            for (int s = 0; s < 2; ++s) {
                const int i = rq * 16 + ii + s;
                const float bb0 = pre0 + bc0[ii + s], bb1 = pre1 + bc1[ii + s];
                const size_t go = (size_t)(t0 + i) * 1024 + h * 256 + d0;
                const unsigned qe = cvt_pk_bf16(bf_lo(qv[ii + s]) * 0.0625f * __expf(bb0), bf_hi(qv[ii + s]) * 0.0625f * __expf(bb1));
                const unsigned ke = cvt_pk_bf16(bf_lo(kv[ii + s]) * __expf(-bb0), bf_hi(kv[ii + s]) * __expf(-bb1));
                *(unsigned*)(Q + go) = qe;
                *(LAS unsigned*)(F.lds + GP_QS + i * GP_PITCH + d0 * 2) = qe;
                *(LAS unsigned*)(F.lds + GP_KS + i * GP_PITCH + d0 * 2) = ke;
                k0v[s] = bf_lo(kv[ii + s]) * __expf(bl0 - bb0); k1v[s] = bf_hi(kv[ii + s]) * __expf(bl1 - bb1);
            }
            kd0[ii >> 1] = cvt_pk_bf16(k0v[0], k0v[1]); kd1[ii >> 1] = cvt_pk_bf16(k1v[0], k1v[1]);
        }
        bf16* kdt = (bf16*)(F.ws + WS_KDT) + (size_t)ci * 16384 + rq * 16;
        *(u32x4*)(kdt + (size_t)d0 * 64) = (u32x4){kd0[0], kd0[1], kd0[2], kd0[3]}; *(u32x4*)(kdt + (size_t)d0 * 64 + 8) = (u32x4){kd0[4], kd0[5], kd0[6], kd0[7]};
        *(u32x4*)(kdt + (size_t)(d0 + 1) * 64) = (u32x4){kd1[0], kd1[1], kd1[2], kd1[3]}; *(u32x4*)(kdt + (size_t)(d0 + 1) * 64 + 8) = (u32x4){kd1[4], kd1[5], kd1[6], kd1[7]};
        if (rq == 0) *(f32x2*)((float*)(F.ws + WS_DEC) + (size_t)ci * 256 + d0) = (f32x2){__expf(bl0), __expf(bl1)};
        __syncthreads();
        const int ib = F.wave >> 1;
        bf16* att = (bf16*)(F.ws + WS_ATT) + (size_t)ci * 4096;
#pragma unroll
        for (int jj = 0; jj < 2; ++jj) {
            const int jb = 2 * (F.wave & 1) + jj;
            f32x4 acc = (f32x4){0.f, 0.f, 0.f, 0.f};
            if (jb <= ib) {
#pragma unroll
                for (int kk = 0; kk < 8; ++kk) {
                    const bf16x8 af = *(const LAS bf16x8*)(F.lds + GP_KS + (jb * 16 + fr) * GP_PITCH + (kk * 32 + 8 * fq) * 2);
                    const bf16x8 bfr = *(const LAS bf16x8*)(F.lds + GP_QS + (ib * 16 + fr) * GP_PITCH + (kk * 32 + 8 * fq) * 2);
                    acc = __builtin_amdgcn_mfma_f32_16x16x32_bf16(af, bfr, acc, 0, 0, 0);
                }
            }
            const int i = ib * 16 + fr, j0 = jb * 16 + 4 * fq;
            u32x2 o; o.x = cvt_pk_bf16(j0 <= i ? acc[0] : 0.f, j0 + 1 <= i ? acc[1] : 0.f); o.y = cvt_pk_bf16(j0 + 2 <= i ? acc[2] : 0.f, j0 + 3 <= i ? acc[3] : 0.f);
            *(u32x2*)(att + i * 64 + j0) = o;
        }
        __syncthreads();
        if (h < 3) {
#pragma unroll
            for (int ii = 0; ii < 16; ++ii) { const size_t go = (size_t)(t0 + rq * 16 + ii) * 1024 + (h + 1) * 256 + d0; qv[ii] = *(const unsigned*)(Q + go); kv[ii] = *(const unsigned*)(Kp + go); }
        }
    }
}

template <int W>
__device__ __forceinline__ void pool_item_w(Frame& F, int tile) {
    const int t0 = tile * 64, pos0 = t0 & (SEQ - 1), c = 2 * F.tid;
    const bf16* P = (const bf16*)(F.ws + WS_P) + (size_t)t0 * 1024 + c; bf16* M = (bf16*)(F.ws + WS_M) + (size_t)t0 * 1024 + c;
    unsigned prev[W - 1];
#pragma unroll
    for (int i = 0; i < W - 1; ++i) prev[i] = (pos0 > 0) ? *(const unsigned*)(P - (ptrdiff_t)(W - 1 - i) * 1024) : 0u;
    float s0 = 0.f, s1 = 0.f;
#pragma unroll
    for (int i = 0; i < W - 1; ++i) { s0 += bf_lo(prev[i]); s1 += bf_hi(prev[i]); }
#pragma unroll 1
    for (int blk = 0; blk < 4; ++blk) {
        unsigned cur[16];
#pragma unroll
        for (int t = 0; t < 16; ++t) cur[t] = *(const unsigned*)(P + (size_t)(blk * 16 + t) * 1024);
#pragma unroll
        for (int t = 0; t < 16; ++t) {
            const float c0 = bf_lo(cur[t]), c1 = bf_hi(cur[t]);
            s0 += c0; s1 += c1;
            const int pos = pos0 + blk * 16 + t;
            const float ic = (pos + 1 >= W) ? (1.0f / (float)W) : __builtin_amdgcn_rcpf((float)(pos + 1));
            *(unsigned*)(M + (size_t)(blk * 16 + t) * 1024) = cvt_pk_bf16(s0 * ic - c0, s1 * ic - c1);
            const unsigned old = (t >= W - 1) ? cur[t - (W - 1) < 0 ? 0 : t - (W - 1)] : prev[t < W - 1 ? t : 0];
            s0 -= bf_lo(old); s1 -= bf_hi(old);
        }
#pragma unroll
        for (int i = 0; i < W - 1; ++i) prev[i] = cur[16 - (W - 1) + i];
    }
}
__device__ __forceinline__ void pool_item(Frame& F, int tile) {
    const int gi = F.wave >> 1;
    if (gi == 0) pool_item_w<2>(F, tile); else if (gi == 1) pool_item_w<4>(F, tile); else if (gi == 2) pool_item_w<8>(F, tile); else pool_item_w<16>(F, tile);
}
__device__ __forceinline__ void ph3(Frame& F, int mode) {
    for (int it = F.wg; it < 512; it += F.G) pool_item(F, it);
    for (int it = F.wg; it < 512; it += F.G) gla_prep_tile(F, it);
}


constexpr int GS_QP = 272, GS_KTP = 144, GS_ATP = 144;
constexpr int GS_QS = 0, GS_KT = GS_QS + 64 * GS_QP, GS_ATT = GS_KT + 128 * GS_KTP, GS_DEC = GS_ATT + 32 * GS_ATP, GS_VS = GS_DEC + 512, GS_STAGE = GS_VS + 8 * 2048;
static_assert(2 * GS_STAGE <= RING_BYTES && GS_STAGE % 16 == 0, "scan LDS");
struct ScanRegs { u32x4 pq[2], pk[2], pv[2], pa; };
__device__ __forceinline__ void gla_scan_unit(Frame& F, int unit) {
    const int kh = unit & 1, dvq = (unit >> 1) & 3, bh = unit >> 3, h = bh & 3, b = bh >> 2;
    const int fr = F.lane & 15, fq = F.lane >> 4, dvh = dvq * 128 + F.wave * 16;
    const bf16* Q = (const bf16*)(F.ws + WS_Q); const bf16* KDT = (const bf16*)(F.ws + WS_KDT); const bf16* ATT = (const bf16*)(F.ws + WS_ATT);
    const float* DEC = (const float*)(F.ws + WS_DEC); const bf16* V = (const bf16*)(F.ws + WS_V);
    bf16* Ob = kh == 0 ? (bf16*)(F.ws + WS_O) + h * 512 + dvh : (bf16*)(F.ws + (h < 2 ? WS_K : WS_P)) + (h & 1) * 512 + dvh;
    const int Old = kh == 0 ? 2048 : 1024;
    u32x4 Sb[4];
#pragma unroll
    for (int t = 0; t < 4; ++t) Sb[t] = (u32x4){0u, 0u, 0u, 0u};
    ScanRegs R0, R1;
    const unsigned qoff0 = (unsigned)((F.tid >> 4) * 1024 + (F.tid & 15) * 8) * 2u, qoff1 = qoff0 + 32u * 1024u * 2u;
    const unsigned koff = (unsigned)F.tid * 16u, voff = (unsigned)F.lane * 4096u;
    const unsigned lq0 = (unsigned)((F.tid >> 4) * GS_QP + (F.tid & 15) * 16), lq1 = lq0 + 32u * GS_QP;
    const unsigned lk0 = (unsigned)((F.tid >> 3) * GS_KTP + (F.tid & 7) * 16), lk1 = lk0 + 64u * GS_KTP;
    const unsigned la = F.tid < 256 ? (unsigned)(GS_ATT + (F.tid >> 3) * GS_ATP + (F.tid & 7) * 16) : (unsigned)(GS_DEC + (F.tid - 256) * 16);
#define GS_LOAD(R, n_) do { const int ci_ = bh * 128 + (n_); const size_t t0_ = (size_t)b * SEQ + (size_t)(n_) * 64; \
        const char* qn_ = (const char*)(Q + t0_ * 1024 + h * 256 + kh * 128); const char* kn_ = (const char*)(KDT + (size_t)ci_ * 16384 + kh * 8192); \
        R.pq[0] = *(const u32x4*)(qn_ + qoff0); R.pq[1] = *(const u32x4*)(qn_ + qoff1); R.pk[0] = *(const u32x4*)(kn_ + koff); R.pk[1] = *(const u32x4*)(kn_ + koff + 8192); \
        const char* vn_ = (const char*)(V + t0_ * 2048 + h * 512 + dvh); R.pv[0] = *(const u32x4*)(vn_ + voff); R.pv[1] = *(const u32x4*)(vn_ + voff + 16); \
        if (F.tid < 256) R.pa = *(const u32x4*)((const char*)(ATT + (size_t)ci_ * 4096 + kh * 2048) + koff); \
        else if (F.tid < 288) R.pa = *(const u32x4*)((const char*)(DEC + (size_t)ci_ * 256 + kh * 128) + (koff - 4096u)); } while (0)
#define GS_STORE(R, st_) do { LAS unsigned char* sb_ = F.lds + (st_) * GS_STAGE; \
        *(LAS u32x4*)(sb_ + GS_QS + lq0) = R.pq[0]; *(LAS u32x4*)(sb_ + GS_QS + lq1) = R.pq[1]; *(LAS u32x4*)(sb_ + GS_KT + lk0) = R.pk[0]; *(LAS u32x4*)(sb_ + GS_KT + lk1) = R.pk[1]; \
        *(LAS u32x4*)(sb_ + GS_VS + F.wave * 2048 + F.lane * 32) = R.pv[0]; *(LAS u32x4*)(sb_ + GS_VS + F.wave * 2048 + F.lane * 32 + 16) = R.pv[1]; \
        if (F.tid < 288) *(LAS u32x4*)(sb_ + la) = R.pa; } while (0)
#define GS_STEP(n_, RL, RS) do { \
        const size_t t0 = (size_t)b * SEQ + (size_t)(n_) * 64; \
        const LAS unsigned char* sb = F.lds + ((n_) & 1) * GS_STAGE; \
        if ((n_) + 2 < 128) GS_LOAD(RL, (n_) + 2); \
        const LAS unsigned char* vs = sb + GS_VS + F.wave * 2048; \
        bf16x8 vf[2]; \
        _Pragma("unroll") for (int ks = 0; ks < 2; ++ks) { const int q = (F.lane & 15) >> 2, p = F.lane & 3; \
            const s16x4 lo = __builtin_amdgcn_ds_read_tr16_b64_v4i16((LAS s16x4*)(vs + (32 * ks + 8 * fq + q) * 32 + p * 8)); \
            const s16x4 hi = __builtin_amdgcn_ds_read_tr16_b64_v4i16((LAS s16x4*)(vs + (32 * ks + 8 * fq + 4 + q) * 32 + p * 8)); \
            vf[ks] = (bf16x8){lo[0], lo[1], lo[2], lo[3], hi[0], hi[1], hi[2], hi[3]}; } \
        f32x4 oacc[4]; \
        _Pragma("unroll") for (int tb = 0; tb < 4; ++tb) oacc[tb] = (f32x4){0.f, 0.f, 0.f, 0.f}; \
        _Pragma("unroll") for (int kb = 0; kb < 4; ++kb) { \
            const u32x4 sfw = Sb[kb]; const bf16x8 sf = __builtin_bit_cast(bf16x8, sfw); \
            bf16x8 qf[4]; \
            _Pragma("unroll") for (int tb = 0; tb < 4; ++tb) { const LAS unsigned char* qp = sb + GS_QS + (tb * 16 + fr) * GS_QP + kb * 64 + fq * 8; \
                const u32x2 qa = *(const LAS u32x2*)qp, qb = *(const LAS u32x2*)(qp + 32); qf[tb] = __builtin_bit_cast(bf16x8, (u32x4){qa.x, qa.y, qb.x, qb.y}); } \
            bf16x8 kf[2][2]; f32x4 dc[2]; \
            _Pragma("unroll") for (int tt = 0; tt < 2; ++tt) { dc[tt] = *(const LAS f32x4*)(sb + GS_DEC + (2 * kb + tt) * 64 + fq * 16); \
                _Pragma("unroll") for (int ks = 0; ks < 2; ++ks) kf[tt][ks] = *(const LAS bf16x8*)(sb + GS_KT + ((2 * kb + tt) * 16 + fr) * GS_KTP + ks * 64 + fq * 16); } \
            _Pragma("unroll") for (int tb = 0; tb < 4; ++tb) oacc[tb] = __builtin_amdgcn_mfma_f32_16x16x32_bf16(sf, qf[tb], oacc[tb], 0, 0, 0); \
            f32x4 s0 = (f32x4){bf_lo(sfw.x), bf_hi(sfw.x), bf_lo(sfw.y), bf_hi(sfw.y)} * dc[0], s1 = (f32x4){bf_lo(sfw.z), bf_hi(sfw.z), bf_lo(sfw.w), bf_hi(sfw.w)} * dc[1]; \
            s0 = __builtin_amdgcn_mfma_f32_16x16x32_bf16(kf[0][0], vf[0], s0, 0, 0, 0); s1 = __builtin_amdgcn_mfma_f32_16x16x32_bf16(kf[1][0], vf[0], s1, 0, 0, 0); \
            s0 = __builtin_amdgcn_mfma_f32_16x16x32_bf16(kf[0][1], vf[1], s0, 0, 0, 0); s1 = __builtin_amdgcn_mfma_f32_16x16x32_bf16(kf[1][1], vf[1], s1, 0, 0, 0); \
            Sb[kb] = (u32x4){cvt_pk_bf16(s0[0], s0[1]), cvt_pk_bf16(s0[2], s0[3]), cvt_pk_bf16(s1[0], s1[1]), cvt_pk_bf16(s1[2], s1[3])}; \
        } \
        _Pragma("unroll") for (int t2 = 0; t2 < 2; ++t2) {        \
            const bf16x8 a0 = *(const LAS bf16x8*)(sb + GS_ATT + (t2 * 16 + fr) * GS_ATP + fq * 16), a1 = *(const LAS bf16x8*)(sb + GS_ATT + (t2 * 16 + fr) * GS_ATP + 64 + fq * 16); \
            f32x4 oo = kh == 0 ? oacc[t2] : oacc[2 + t2]; \
            oo = __builtin_amdgcn_mfma_f32_16x16x32_bf16(vf[0], a0, oo, 0, 0, 0); oo = __builtin_amdgcn_mfma_f32_16x16x32_bf16(vf[1], a1, oo, 0, 0, 0); \
            if (kh == 0) oacc[t2] = oo; else oacc[2 + t2] = oo; } \
        _Pragma("unroll") for (int tb = 0; tb < 4; ++tb) { u32x2 o; o.x = cvt_pk_bf16(oacc[tb][0], oacc[tb][1]); o.y = cvt_pk_bf16(oacc[tb][2], oacc[tb][3]); \
            *(u32x2*)(Ob + (t0 + 16 * tb + fr) * Old + 4 * fq) = o; } \
        if ((n_) + 1 < 128) GS_STORE(RS, ((n_) + 1) & 1); \
        __syncthreads(); } while (0)
    GS_LOAD(R0, 0); GS_LOAD(R1, 1);
    GS_STORE(R0, 0);
    __syncthreads();
#pragma unroll 1
    for (int n = 0; n < 128; n += 2) {
        GS_STEP(n, R0, R1);
        GS_STEP(n + 1, R1, R0);
    }
#undef GS_LOAD
#undef GS_STORE
#undef GS_STEP
}

__device__ __forceinline__ void ph5(Frame& F) {
    const Args& a = *F.a;
    bf16* O = (bf16*)(F.ws + WS_O); const bf16* Gp = (const bf16*)(F.ws + WS_G);
    const f32x4 gn0 = *(const f32x4*)(a.in[I_GLAN] + 8 * F.lane), gn1 = *(const f32x4*)(a.in[I_GLAN] + 8 * F.lane + 4);
    const float gn[8] = {gn0.x, gn0.y, gn0.z, gn0.w, gn1.x, gn1.y, gn1.z, gn1.w};
    for (int r = 0; r < 16; ++r) {
        const size_t row = (size_t)F.wg * 128 + F.wave * 16 + r;
#pragma unroll
        for (int j = 0; j < 4; ++j) {
            const size_t off = row * 2048 + 512 * j + 8 * F.lane;
            const u32x4 ov = __builtin_nontemporal_load((const u32x4*)(O + off)), gv = __builtin_nontemporal_load((const u32x4*)(Gp + off));
            const u32x4 o1 = __builtin_nontemporal_load((const u32x4*)((const bf16*)(F.ws + (j < 2 ? WS_K : WS_P)) + row * 1024 + (j & 1) * 512 + 8 * F.lane));
            float o[8] = {bf_lo(ov.x) + bf_lo(o1.x), bf_hi(ov.x) + bf_hi(o1.x), bf_lo(ov.y) + bf_lo(o1.y), bf_hi(ov.y) + bf_hi(o1.y), bf_lo(ov.z) + bf_lo(o1.z), bf_hi(ov.z) + bf_hi(o1.z), bf_lo(ov.w) + bf_lo(o1.w), bf_hi(ov.w) + bf_hi(o1.w)};
            const float g[8] = {bf_lo(gv.x), bf_hi(gv.x), bf_lo(gv.y), bf_hi(gv.y), bf_lo(gv.z), bf_hi(gv.z), bf_lo(gv.w), bf_hi(gv.w)};
            float s = 0.f;
#pragma unroll
            for (int q = 0; q < 8; ++q) s += o[q] * o[q];
            const float rstd = rsqrtf(wave_sum(s) * (1.0f / 512.0f) + EPS);
#pragma unroll
            for (int q = 0; q < 8; ++q) o[q] = o[q] * rstd * gn[q] * siluf_(g[q]);
            *(u32x2*)(F.ws + WS_U8 + off) = (u32x2){pk4_fp8(o[0], o[1], o[2], o[3]), pk4_fp8(o[4], o[5], o[6], o[7])};
        }
    }
}

struct EpiPool {
    static constexpr bool PERM = true;
    unsigned char* ws;
    __device__ __forceinline__ void operator()(AccT acc, const pg8::Unit& u, int wr, int wc, int fr, int fq) const {
        const int row0 = u.pm * 256 + wr * 64 + fr;
        const size_t cb = u.pn * 256 + wc * 32 + 8 * fq;
#pragma unroll
        for (int ai = 0; ai < 2; ++ai) {
            u32x4 gq[4][2];
#pragma unroll
            for (int m = 0; m < 4; ++m) { const size_t ro = (size_t)(row0 + ai * 128 + m * 16) * D + cb;
#pragma unroll
                for (int bj = 0; bj < 2; ++bj) gq[m][bj] = __builtin_nontemporal_load((const u32x4*)((const bf16*)(ws + WS_GB) + ro + bj * 128)); }
#pragma unroll
            for (int m = 0; m < 4; ++m) { const size_t ro = (size_t)(row0 + ai * 128 + m * 16) * D + cb;
#pragma unroll
                for (int bj = 0; bj < 2; ++bj) { const f32x4 v0 = acc[ai][bj][m][0], v1 = acc[ai][bj][m][1]; const u32x4 g = gq[m][bj];
                    u32x4 w; w.x = cvt_pk_bf16(v0[0] * sigmoidf_(bf_lo(g.x)), v0[1] * sigmoidf_(bf_hi(g.x))); w.y = cvt_pk_bf16(v0[2] * sigmoidf_(bf_lo(g.y)), v0[3] * sigmoidf_(bf_hi(g.y)));
                    w.z = cvt_pk_bf16(v1[0] * sigmoidf_(bf_lo(g.z)), v1[1] * sigmoidf_(bf_hi(g.z))); w.w = cvt_pk_bf16(v1[2] * sigmoidf_(bf_lo(g.w)), v1[3] * sigmoidf_(bf_hi(g.w)));
                    *(u32x4*)((bf16*)(ws + WS_U) + ro + bj * 128) = w; } }
        }
    }
};
struct EpiMergeA {
    static constexpr bool PERM = true;
    unsigned char* ws;
    __device__ __forceinline__ void operator()(AccT acc, const pg8::Unit& u, int wr, int wc, int fr, int fq) const {
        const int row0 = u.pm * 256 + wr * 64 + fr;
        const size_t cb = u.pn * 256 + wc * 32 + 8 * fq;
#pragma unroll
        for (int ai = 0; ai < 2; ++ai) {
            u32x4 gq[4][2], yq[4][2];
#pragma unroll
            for (int m = 0; m < 4; ++m) { const size_t ro = (size_t)(row0 + ai * 128 + m * 16) * D + cb;
#pragma unroll
                for (int bj = 0; bj < 2; ++bj) { gq[m][bj] = __builtin_nontemporal_load((const u32x4*)((const bf16*)(ws + WS_GA) + ro + bj * 128)); yq[m][bj] = *(const u32x4*)((const bf16*)(ws + WS_U) + ro + bj * 128); } }
#pragma unroll
            for (int m = 0; m < 4; ++m) { const size_t ro = (size_t)(row0 + ai * 128 + m * 16) * D + cb;
#pragma unroll
                for (int bj = 0; bj < 2; ++bj) { const f32x4 v0 = acc[ai][bj][m][0] * (1.0f / W8_SCALE), v1 = acc[ai][bj][m][1] * (1.0f / W8_SCALE); const u32x4 g = gq[m][bj], y = yq[m][bj];
                    u32x4 w; w.x = cvt_pk_bf16(bf_lo(y.x) + v0[0] * sigmoidf_(bf_lo(g.x)), bf_hi(y.x) + v0[1] * sigmoidf_(bf_hi(g.x)));
                    w.y = cvt_pk_bf16(bf_lo(y.y) + v0[2] * sigmoidf_(bf_lo(g.y)), bf_hi(y.y) + v0[3] * sigmoidf_(bf_hi(g.y)));
                    w.z = cvt_pk_bf16(bf_lo(y.z) + v1[0] * sigmoidf_(bf_lo(g.z)), bf_hi(y.z) + v1[1] * sigmoidf_(bf_hi(g.z)));
                    w.w = cvt_pk_bf16(bf_lo(y.w) + v1[2] * sigmoidf_(bf_lo(g.w)), bf_hi(y.w) + v1[3] * sigmoidf_(bf_hi(g.w)));
                    *(u32x4*)((bf16*)(ws + WS_U) + ro + bj * 128) = w; } }
        }
    }
};
struct EpiH1 {
    static constexpr bool PERM = true;
    const float* x; bf16* out; const float* modf; float* rss;
    __device__ __forceinline__ void operator()(AccT acc, const pg8::Unit& u, int wr, int wc, int fr, int fq) const {
        const int row0 = u.pm * 256 + wr * 64 + fr, col0 = u.pn * 256 + wc * 32 + 8 * fq;
        const float* g1 = modf + (size_t)(u.pm >> 5) * (6 * D) + 2 * D + col0;
        f32x4 gv[2][2];
#pragma unroll
        for (int bj = 0; bj < 2; ++bj)
#pragma unroll
            for (int n = 0; n < 2; ++n) gv[bj][n] = *(const f32x4*)(g1 + bj * 128 + n * 4);
#pragma unroll
        for (int ai = 0; ai < 2; ++ai) {
            f32x4 xv[4][2][2];
#pragma unroll
            for (int m = 0; m < 4; ++m) { const size_t ro = (size_t)(row0 + ai * 128 + m * 16) * D + col0;
#pragma unroll
                for (int bj = 0; bj < 2; ++bj)
#pragma unroll
                    for (int n = 0; n < 2; ++n) xv[m][bj][n] = __builtin_nontemporal_load((const f32x4*)(x + ro + bj * 128 + n * 4)); }
#pragma unroll
            for (int m = 0; m < 4; ++m) { const size_t ro = (size_t)(row0 + ai * 128 + m * 16) * D + col0;
                float ss = 0.f;
#pragma unroll
                for (int bj = 0; bj < 2; ++bj) { const f32x4 h0 = xv[m][bj][0] + gv[bj][0] * acc[ai][bj][m][0], h1 = xv[m][bj][1] + gv[bj][1] * acc[ai][bj][m][1];
                    u32x4 w; w.x = cvt_pk_bf16(h0.x, h0.y); w.y = cvt_pk_bf16(h0.z, h0.w); w.z = cvt_pk_bf16(h1.x, h1.y); w.w = cvt_pk_bf16(h1.z, h1.w);
                    *(u32x4*)(out + ro + bj * 128) = w;
                    ss += ((h0.x * h0.x + h0.y * h0.y) + (h0.z * h0.z + h0.w * h0.w)) + ((h1.x * h1.x + h1.y * h1.y) + (h1.z * h1.z + h1.w * h1.w)); }
                ss += __shfl_xor(ss, 16); ss += __shfl_xor(ss, 32);
                if (fq == 0) rss[(size_t)(row0 + ai * 128 + m * 16) * 32 + u.pn * 4 + wc] = ss; }
        }
    }
};
__device__ __forceinline__ void ph6(Frame& F) {
    pg8::StaticOrder S; S.init(T, D, F.G, F.wg);
    SrcZ<true> X{F.ws + WS_U8, F.ws + WS_WA, D, D, D, ZMap{0, 0, 0}};
    EpiMergeA E{F.ws};
    pg8::gemm_phase(F.lds, S, X, E);
}
__device__ __forceinline__ void pool_gemm(Frame& F, int rank, int nwg, int off, int lim) {
    pg8::StaticOrder S; S.init(T, D, nwg, rank); S.off = off; S.lim = lim;
    SrcDense X{(const bf16*)(F.ws + WS_M), (const bf16*)(F.ws + WS_WPB), 1024, 1024, 1024};
    EpiPool E{F.ws};
    pg8::gemm_phase(F.lds, S, X, E);
}
__device__ __forceinline__ void ph4(Frame& F) {
    constexpr int POOL_A = 640, NPOOLWG = 50;
    if (F.wg < 128) { const int x = F.wg & 7, j = F.wg >> 3; gla_scan_unit(F, (2 * x + (j >> 3)) * 8 + (j & 7)); __syncthreads(); pool_gemm(F, F.wg, 128, POOL_A, 1024); }
    else if (F.wg >= 256 - NPOOLWG) pool_gemm(F, F.wg - (256 - NPOOLWG), NPOOLWG, 0, POOL_A);
    cvt_experts(F);
}
__device__ __forceinline__ void ph8(Frame& F) {
    pg8::StaticOrder S; S.init(T, D, F.G, F.wg);
    SrcDense X{(const bf16*)(F.ws + WS_U), (const bf16*)(F.ws + WS_WOUT), D, D, D};
    EpiH1 E{F.a->in[I_X], (bf16*)(F.ws + WS_H1), (const float*)(F.ws + WS_MODF), (float*)(F.ws + WS_RSS)};
    pg8::gemm_phase(F.lds, S, X, E);
}


constexpr int MISC_TB = 16, MISC_CNT = 96;
__device__ __forceinline__ void ph9(Frame& F) {
    const Args& a = *F.a;
    const int b = F.wg / 64, fr = F.lane & 15, fq = F.lane >> 4;
    const float* mf = (const float*)(F.ws + WS_MODF) + (size_t)b * 6 * D;
    constexpr int BST = 16384, BPITCH = 272, BHL = 80 * BPITCH, BSTAGE = 2 * BHL;
    LAS float* gm = (LAS float*)F.lds; LAS float* sh = gm + D; LAS float* lg = (LAS float*)(F.lds + BST) + F.wave * (16 * 80);
    for (int c = F.tid; c < D; c += NTHR) { gm[c] = a.in[I_NFFN][c] * (1.0f + mf[4 * D + c]); sh[c] = mf[3 * D + c]; }
    const int r0 = F.wg * 128 + F.wave * 16;
    float myrstd;
    { const float* rs = (const float*)(F.ws + WS_RSS) + (size_t)(r0 + fr) * 32; float s = 0.f;
#pragma unroll
      for (int q = 0; q < 8; ++q) { const f32x4 p = *(const f32x4*)(rs + 4 * q); s += (p.x + p.y) + (p.z + p.w); }
      myrstd = rsqrtf(s * (1.0f / D) + EPS); }
    f32x4 acc[5];
#pragma unroll
    for (int nb = 0; nb < 5; ++nb) acc[nb] = (f32x4){0.f, 0.f, 0.f, 0.f};
    const bf16* hrow = (const bf16*)(F.ws + WS_H1) + (size_t)(r0 + fr) * D + 8 * fq;
    unsigned char* U2 = (unsigned char*)(F.ws + WS_U) + (size_t)(r0 + fr) * D + 8 * fq;
    const bf16* W = (const bf16*)(F.ws + WS_WRT);
    u32x4 pb[5]; u32x4 xc[4], xn[4];
#define P9_LOADB(s_) do { _Pragma("unroll") for (int j = 0; j < 5; ++j) { const int p = F.tid + 512 * j, hl = p / 1280, rem = p - hl * 1280; \
        pb[j] = *(const u32x4*)(W + (size_t)hl * 80 * D + (size_t)(rem >> 4) * D + (s_) * 128 + (rem & 15) * 8); } } while (0)
#define P9_STOREB(st_) do { _Pragma("unroll") for (int j = 0; j < 5; ++j) { const int p = F.tid + 512 * j, hl = p / 1280, rem = p - hl * 1280; \
        *(LAS u32x4*)(F.lds + BST + (st_) * BSTAGE + hl * BHL + (rem >> 4) * BPITCH + (rem & 15) * 16) = pb[j]; } } while (0)
#define P9_LOADX(dst_, s_) do { _Pragma("unroll") for (int k4 = 0; k4 < 4; ++k4) dst_[k4] = *(const u32x4*)(hrow + (s_) * 128 + 32 * k4); } while (0)
    P9_LOADB(0); P9_LOADX(xc, 0);
    P9_STOREB(0);
    __syncthreads();
    for (int s = 0; s < 16; ++s) {
        if (s + 1 < 16) { P9_LOADB(s + 1); P9_LOADX(xn, s + 1); }
        const LAS unsigned char* Bs = F.lds + BST + (s & 1) * BSTAGE;
#pragma unroll
        for (int k4 = 0; k4 < 4; ++k4) {
            const int c0 = s * 128 + 32 * k4 + 8 * fq;
            const f32x4 g0 = *(const LAS f32x4*)(gm + c0), g1 = *(const LAS f32x4*)(gm + c0 + 4), s0 = *(const LAS f32x4*)(sh + c0), s1 = *(const LAS f32x4*)(sh + c0 + 4);
            const u32x4 xr = xc[k4]; const f32x4 x0 = (f32x4){bf_lo(xr.x), bf_hi(xr.x), bf_lo(xr.y), bf_hi(xr.y)}, x1 = (f32x4){bf_lo(xr.z), bf_hi(xr.z), bf_lo(xr.w), bf_hi(xr.w)};
            const f32x4 u0 = x0 * myrstd * g0 + s0, u1 = x1 * myrstd * g1 + s1;
            u32x4 hw; hw.x = cvt_pk_bf16(u0[0], u0[1]); hw.y = cvt_pk_bf16(u0[2], u0[3]); hw.z = cvt_pk_bf16(u1[0], u1[1]); hw.w = cvt_pk_bf16(u1[2], u1[3]);
            u32x4 lw; lw.x = cvt_pk_bf16(u0[0] - bf_lo(hw.x), u0[1] - bf_hi(hw.x)); lw.y = cvt_pk_bf16(u0[2] - bf_lo(hw.y), u0[3] - bf_hi(hw.y));
            lw.z = cvt_pk_bf16(u1[0] - bf_lo(hw.z), u1[1] - bf_hi(hw.z)); lw.w = cvt_pk_bf16(u1[2] - bf_lo(hw.w), u1[3] - bf_hi(hw.w));
            *(u32x2*)(U2 + s * 128 + 32 * k4) = (u32x2){pk4_fp8(u0[0], u0[1], u0[2], u0[3]), pk4_fp8(u1[0], u1[1], u1[2], u1[3])};
            const bf16x8 ah = __builtin_bit_cast(bf16x8, hw), al = __builtin_bit_cast(bf16x8, lw);
#pragma unroll
            for (int nb = 0; nb < 5; ++nb) {
                const bf16x8 bh = *(const LAS bf16x8*)(Bs + (nb * 16 + fr) * BPITCH + (32 * k4 + 8 * fq) * 2), bl = *(const LAS bf16x8*)(Bs + BHL + (nb * 16 + fr) * BPITCH + (32 * k4 + 8 * fq) * 2);
                acc[nb] = __builtin_amdgcn_mfma_f32_16x16x32_bf16(ah, bh, acc[nb], 0, 0, 0);
                acc[nb] = __builtin_amdgcn_mfma_f32_16x16x32_bf16(al, bh, acc[nb], 0, 0, 0);
                acc[nb] = __builtin_amdgcn_mfma_f32_16x16x32_bf16(ah, bl, acc[nb], 0, 0, 0);
            }
        }
        if (s + 1 < 16) { P9_STOREB((s + 1) & 1);
#pragma unroll
            for (int q = 0; q < 4; ++q) xc[q] = xn[q]; }
        __syncthreads();
    }
#undef P9_LOADB
#undef P9_STOREB
#undef P9_LOADX
#pragma unroll
    for (int nb = 0; nb < 5; ++nb)
#pragma unroll
        for (int r = 0; r < 4; ++r) lg[(4 * fq + r) * 80 + 16 * nb + fr] = acc[nb][r];
    __syncthreads();
    if (F.lane < 16) {
        const int tok = r0 + F.lane; const LAS float* L = lg + F.lane * 80;
        float gl[8]; float gmax = -3.0e38f; int gsel = 0;
#pragma unroll
        for (int j = 0; j < 8; ++j) { gl[j] = L[j] + a.in[I_BRG][j]; if (gl[j] > gmax) { gmax = gl[j]; gsel = j; } }
        float gs = 0.f;
#pragma unroll
        for (int j = 0; j < 8; ++j) gs += __expf(gl[j] - gmax);
        const float pg = 1.0f / gs;
        float v0 = -3.0e38f, v1 = -3.0e38f; int i0 = 0, i1 = 0;
#pragma unroll
        for (int j = 0; j < 8; ++j) {
            const float e = L[8 + gsel * 8 + j] + a.in[I_BRE][gsel * 8 + j];
            if (e > v0) { v1 = v0; i1 = i0; v0 = e; i0 = j; } else if (e > v1) { v1 = e; i1 = j; }
        }
        const float w0 = 1.0f / (1.0f + __expf(v1 - v0)), w1 = 1.0f - w0;
        const int e0 = gsel * 8 + i0, e1 = gsel * 8 + i1;
        unsigned* cnt = (unsigned*)(F.ws + WS_CTL) + CW_CNT;
        const int p0 = (int)atomicAdd(cnt + 64 * e0, 1u), p1 = (int)atomicAdd(cnt + 64 * e1, 1u);
        int* list = (int*)(F.ws + WS_LIST);
        list[(size_t)e0 * T + p0] = tok; list[(size_t)e1 * T + p1] = tok;
        ((int4*)(F.ws + WS_ASG))[tok] = make_int4(e0, p0, e1, p1);
        ((f32x2*)(F.ws + WS_ASGW))[tok] = (f32x2){pg * w0, pg * w1};
    }
    __syncthreads();
}

constexpr int MISC_NFH = 12;
constexpr int LDS_TL = LDS_MISC + 1024;
__device__ __forceinline__ void build_tiles(Frame& F) {
    volatile LAS int* misc = (volatile LAS int*)(F.lds + LDS_MISC);
    volatile LAS int* fl = (volatile LAS int*)(F.lds + LDS_TL); volatile LAS int* hl = fl + 320;
    if (F.tid < 64) {
        unsigned* cnt = (unsigned*)(F.ws + WS_CTL) + CW_CNT;
        const int c = (int)__hip_atomic_load(cnt + 64 * F.tid, RLX_AGENT);
        const int nt = (c + 255) >> 8, half = (nt > 0 && c - (nt - 1) * 256 <= 128) ? 1 : 0, full = nt - half;
        int inc = nt, fin = full, hin = half;
#pragma unroll
        for (int o = 1; o < 64; o <<= 1) { const int t = __shfl_up(inc, o), tf = __shfl_up(fin, o), th = __shfl_up(hin, o); if (F.lane >= o) { inc += t; fin += tf; hin += th; } }
        const int t0 = inc - nt, f0 = fin - full, h0 = hin - half;
        misc[MISC_TB + F.tid] = t0; misc[MISC_CNT + F.tid] = c;
        if (F.tid == 63) { misc[MISC_TB + 64] = inc; misc[MISC_NFH] = fin; misc[MISC_NFH + 1] = hin; }
        for (int j = 0; j < full; ++j) fl[f0 + j] = t0 + j;
        if (half) hl[h0] = t0 + nt - 1;
    }
    __syncthreads();
}

struct SrcGU {
    static constexpr bool GATHER = true, BTILED = true, FP8 = true;
    const unsigned char* A; const unsigned char* Bt; const int* list; const volatile LAS int* cnt; int K, lda, ldb;
    __device__ __forceinline__ const char* a_ptr(const pg8::Unit&) const { return (const char*)A; }
    __device__ __forceinline__ const char* b_ptr(const pg8::Unit& u) const { return (const char*)(Bt + ((size_t)u.e * 2048 + (size_t)u.pn * 256) * ldb); }
    __device__ __forceinline__ int rows(const pg8::Unit& u, int r) const { const int i = u.r0 + r; return i < cnt[u.e] ? list[(size_t)u.e * T + i] : 0; }
};
struct SrcDown {
    static constexpr bool GATHER = false, BTILED = true, FP8 = true;
    const unsigned char* A; const unsigned char* Bt; int K, lda, ldb;
    __device__ __forceinline__ const char* a_ptr(const pg8::Unit& u) const { return (const char*)(A + (size_t)u.pm * 256 * lda); }
    __device__ __forceinline__ const char* b_ptr(const pg8::Unit& u) const { return (const char*)(Bt + ((size_t)u.e * 2048 + (size_t)u.pn * 256) * ldb); }
    __device__ __forceinline__ int rows(const pg8::Unit&, int r) const { return r; }
};
struct EpiHid {
    static constexpr bool PERM = false;
    unsigned char* H;
    __device__ __forceinline__ void operator()(AccT acc, const pg8::Unit& u, int wr, int wc, int fr, int fq) const {
        unsigned char* base = H + (size_t)(u.pm * 256 + wr * 64 + fr) * EH + u.pn * 128 + wc * 32 + 8 * fq;
        constexpr float IS = 1.0f / W8_SCALE, OS = H8_SCALE / W8_SCALE;
#pragma unroll
        for (int ai = 0; ai < 2; ++ai)
#pragma unroll
            for (int m = 0; m < 4; ++m) {
                const f32x4 g0 = acc[ai][0][m][0] * IS, u0 = acc[ai][0][m][1] * OS, g1 = acc[ai][1][m][0] * IS, u1 = acc[ai][1][m][1] * OS;
                u32x2 w; w.x = pk4_fp8(sat8(siluf_(g0[0]) * u0[0]), sat8(siluf_(g0[1]) * u0[1]), sat8(siluf_(g0[2]) * u0[2]), sat8(siluf_(g0[3]) * u0[3]));
                w.y = pk4_fp8(sat8(siluf_(g1[0]) * u1[0]), sat8(siluf_(g1[1]) * u1[1]), sat8(siluf_(g1[2]) * u1[2]), sat8(siluf_(g1[3]) * u1[3]));
                *(u32x2*)(base + (size_t)(ai * 128 + m * 16) * EH) = w;
            }
    }
};
struct EpiY {
    static constexpr bool PERM = true;
    unsigned char* Y;
    __device__ __forceinline__ void operator()(AccT acc, const pg8::Unit& u, int wr, int wc, int fr, int fq) const {
        unsigned char* base = Y + (size_t)(u.pm * 256 + wr * 64 + fr) * D + u.pn * 256 + wc * 32 + 8 * fq;
#pragma unroll
        for (int ai = 0; ai < 2; ++ai)
#pragma unroll
            for (int m = 0; m < 4; ++m)
#pragma unroll
                for (int bj = 0; bj < 2; ++bj) { const f32x4 v0 = acc[ai][bj][m][0] * (Y8_SCALE / (W8_SCALE * H8_SCALE)), v1 = acc[ai][bj][m][1] * (Y8_SCALE / (W8_SCALE * H8_SCALE));
                    *(u32x2*)(base + (size_t)(ai * 128 + m * 16) * D + bj * 128) = (u32x2){pk4_fp8(sat8(v0[0]), sat8(v0[1]), sat8(v0[2]), sat8(v0[3])), pk4_fp8(sat8(v1[0]), sat8(v1[1]), sat8(v1[2]), sat8(v1[3]))}; }
    }
};
__device__ __forceinline__ void ph10(Frame& F) {
    build_tiles(F);
    const volatile LAS int* misc = (const volatile LAS int*)(F.lds + LDS_MISC);
    pg8::GroupOrder S{misc + MISC_TB, misc + MISC_CNT, (const volatile LAS int*)(F.lds + LDS_TL), (const volatile LAS int*)(F.lds + LDS_TL) + 320, misc + MISC_NFH, F.G, F.wg};
    SrcGU X{(const unsigned char*)(F.ws + WS_U), (const unsigned char*)(F.ws + WS_WGU), (const int*)(F.ws + WS_LIST), misc + MISC_CNT, D, D, D};
    EpiHid E{(unsigned char*)(F.ws + WS_H)};
    pg8::gemm_phase(F.lds, S, X, E);
}
__device__ __forceinline__ void ph11(Frame& F) {
    build_tiles(F);
    const volatile LAS int* misc = (const volatile LAS int*)(F.lds + LDS_MISC);
    pg8::GroupOrder S{misc + MISC_TB, misc + MISC_CNT, (const volatile LAS int*)(F.lds + LDS_TL), (const volatile LAS int*)(F.lds + LDS_TL) + 320, misc + MISC_NFH, F.G, F.wg};
    SrcDown X{(const unsigned char*)(F.ws + WS_H), (const unsigned char*)(F.ws + WS_WD), EH, EH, EH};
    EpiY E{F.ws + WS_Y};
    pg8::gemm_phase(F.lds, S, X, E);
}

struct FinRow { f32x4 v[8]; unsigned y0[8], y1[8]; };
__device__ __forceinline__ void ph_final(Frame& F, int mode) {
    const Args& a = *F.a;
    build_tiles(F);
    const volatile LAS int* tb = (const volatile LAS int*)(F.lds + LDS_MISC) + MISC_TB;
    const int row0 = (F.wg * NWAVES + F.wave) * 16;
    const float* g2 = (const float*)(F.ws + WS_MODF) + (size_t)(F.wg / 64) * 6 * D + 5 * D;
    const unsigned char* Y = F.ws + WS_Y;
    f32x4 gg[8], nf[8];
#pragma unroll
    for (int j = 0; j < 8; ++j) { gg[j] = *(const f32x4*)(g2 + 4 * F.lane + 256 * j); nf[j] = *(const f32x4*)(a.in[I_NFIN] + 4 * F.lane + 256 * j); }
    const int l16 = F.lane & 15;
    const int4 as = ((const int4*)(F.ws + WS_ASG))[row0 + l16]; const float* wvp = (const float*)(F.ws + WS_ASGW) + 2 * (size_t)(row0 + l16); const int wvx = __builtin_bit_cast(int, wvp[0]), wvy = __builtin_bit_cast(int, wvp[1]);
    const unsigned s0v = (unsigned)(tb[as.x] * 256 + as.y), s1v = (unsigned)(tb[as.z] * 256 + as.w);
#define FIN_LOAD(R, r_) do { const unsigned s0 = (unsigned)__builtin_amdgcn_readlane((int)s0v, (r_)), s1 = (unsigned)__builtin_amdgcn_readlane((int)s1v, (r_)); \
        const bf16* src = (const bf16*)(F.ws + WS_H1) + (size_t)(row0 + (r_)) * D + 4 * F.lane; const unsigned char* y0p = Y + (size_t)s0 * D + 4 * F.lane; const unsigned char* y1p = Y + (size_t)s1 * D + 4 * F.lane; \
        _Pragma("unroll") for (int j = 0; j < 8; ++j) { { const u32x2 hb = __builtin_nontemporal_load((const u32x2*)(src + 256 * j)); R.v[j].x = __uint_as_float(hb.x); R.v[j].y = __uint_as_float(hb.y); } R.y0[j] = __builtin_nontemporal_load((const unsigned*)(y0p + 256 * j)); R.y1[j] = __builtin_nontemporal_load((const unsigned*)(y1p + 256 * j)); } } while (0)
#define FIN_DO(R, r_) do { const float w0 = __builtin_bit_cast(float, __builtin_amdgcn_readlane(wvx, (r_))) * (1.0f / Y8_SCALE), w1 = __builtin_bit_cast(float, __builtin_amdgcn_readlane(wvy, (r_))) * (1.0f / Y8_SCALE); \
        float s = 0.f; \
        _Pragma("unroll") for (int j = 0; j < 8; ++j) { \
            const f32x2 a0 = __builtin_amdgcn_cvt_pk_f32_fp8((int)R.y0[j], false), a1 = __builtin_amdgcn_cvt_pk_f32_fp8((int)R.y0[j], true), b0 = __builtin_amdgcn_cvt_pk_f32_fp8((int)R.y1[j], false), b1 = __builtin_amdgcn_cvt_pk_f32_fp8((int)R.y1[j], true); \
            f32x4 y; y.x = w0 * a0.x + w1 * b0.x; y.y = w0 * a0.y + w1 * b0.y; y.z = w0 * a1.x + w1 * b1.x; y.w = w0 * a1.y + w1 * b1.y; \
            { const unsigned hx = __float_as_uint(R.v[j].x), hy = __float_as_uint(R.v[j].y); R.v[j] = (f32x4){bf_lo(hx), bf_hi(hx), bf_lo(hy), bf_hi(hy)} + gg[j] * y; } s += (R.v[j].x * R.v[j].x + R.v[j].y * R.v[j].y) + (R.v[j].z * R.v[j].z + R.v[j].w * R.v[j].w); } \
        const float rstd = rsqrtf(wave_sum(s) * (1.0f / D) + EPS); \
        float* dst = a.out + (size_t)(row0 + (r_)) * D + 4 * F.lane; \
        _Pragma("unroll") for (int j = 0; j < 8; ++j) __builtin_nontemporal_store(R.v[j] * rstd * nf[j], (f32x4*)(dst + 256 * j)); } while (0)
    FinRow A, B;
    FIN_LOAD(A, 0);
#pragma unroll 1
    for (int r = 0; r < 16; r += 2) {
        FIN_LOAD(B, r + 1);
        FIN_DO(A, r);
        if (r + 2 < 16) FIN_LOAD(A, r + 2);
        FIN_DO(B, r + 1);
    }
#undef FIN_LOAD
#undef FIN_DO
}

__global__ void __launch_bounds__(NTHR, 2) fwd(Args args) {
    extern __shared__ __attribute__((aligned(16))) unsigned char lds_raw[];
    Frame F;
    F.lds = (LAS unsigned char*)lds_raw;
    F.tid = threadIdx.x; F.lane = F.tid & 63; F.wave = __builtin_amdgcn_readfirstlane(F.tid >> 6);
    F.G = gridDim.x; F.wg = blockIdx.x; F.a = &args; F.ws = args.ws;
    volatile LAS unsigned* MISC = (volatile LAS unsigned*)(F.lds + LDS_MISC);
    if (F.tid < 256) MISC[F.tid] = 0u;
    __syncthreads();
    unsigned* ctl = (unsigned*)(args.ws + WS_CTL);
    const int lo = args.ph_lo, hi = args.ph_hi;
    XcdBarrier bar; bar.bar = ctl + CW_BAR; bar.x = 0; bar.st = MISC;
    if (hi - lo > 1) bar = xcd_barrier_post(ctl + CW_BAR, MISC);
#define IN(k) (lo <= (k) && (k) < hi)
#define SEAM(k) do { if (IN(k) && IN((k) + 1)) xcd_barrier(bar); } while (0)
    if (IN(0)) { ph0(F); } SEAM(0);
    if (IN(1)) { ph1(F); } SEAM(1);
    if (IN(2)) { ph2(F); } SEAM(2);
    if (IN(3)) { ph3(F, args.mode); } SEAM(3);
    if (IN(4)) { ph4(F); } SEAM(4);
    if (IN(5)) { ph5(F); } SEAM(5);
    if (IN(6)) { ph6(F); } if (IN(6) && IN(8)) xcd_barrier(bar);
    if (IN(8)) { ph8(F); } SEAM(8);
    if (IN(9)) { ph9(F); } SEAM(9);
    if (IN(10)) { ph10(F); } SEAM(10);
    if (IN(11)) { ph11(F); } SEAM(11);
    if (IN(12)) { ph_final(F, args.mode); }
#undef IN
#undef SEAM
}

extern "C" void kernel_launch(void* const* d_in, const int* in_sizes, int n_in, void* d_out, int out_size, void* d_ws, size_t ws_size, hipStream_t stream) {
    static int grid = 0;
    if (grid == 0) {
        if (n_in != 23 || out_size != T * D || ws_size < WS_END) { fprintf(stderr, "kernel_launch: unexpected sizes (n_in %d out %d ws %zu)\n", n_in, out_size, ws_size); grid = -1; return; }
        int dev = 0, cus = 0, per_cu = 0;
        if (hipGetDevice(&dev) != hipSuccess || hipDeviceGetAttribute(&cus, hipDeviceAttributeMultiprocessorCount, dev) != hipSuccess) { grid = -1; return; }
        if (hipFuncSetAttribute((const void*)fwd, hipFuncAttributeMaxDynamicSharedMemorySize, LDS_BYTES) != hipSuccess) { fprintf(stderr, "kernel_launch: hipFuncSetAttribute failed\n"); grid = -1; return; }
        if (hipOccupancyMaxActiveBlocksPerMultiprocessor(&per_cu, (const void*)fwd, NTHR, LDS_BYTES) != hipSuccess || per_cu < 1) fprintf(stderr, "kernel_launch: occupancy query says %d\n", per_cu);
        (void)hipGetLastError();
        grid = cus;
        if (grid != 256) { fprintf(stderr, "kernel_launch: built for 256 CUs, got %d\n", grid); grid = -1; return; }
    }
    if (grid < 0) return;
    (void)hipMemsetAsync((char*)d_ws + WS_CTL, 0, CTL_ZERO_BYTES, stream);
    Args a{};
    for (int i = 0; i < 23; ++i) a.in[i] = (const float*)d_in[i];
    a.out = (float*)d_out; a.ws = (unsigned char*)d_ws;
    a.ph_lo = 0; a.ph_hi = NPH; a.mode = 0; a.pad = 0;
    hipLaunchKernelGGL(fwd, dim3(grid), dim3(NTHR), LDS_BYTES, stream, a);
}
```
